# Optimizing an MI355X kernel written in HIP

```python
import math
import jax
import jax.numpy as jnp
from jax import lax
import numpy as np

D_MODEL = 2048
BATCH = 2
SEQ = 4096
DEPTH = 2

N_EVEN = (DEPTH + 1) // 2
N_ODD = DEPTH // 2
EPS = 1e-6
MIX_WIDTH = D_MODEL
A_QK_DIM = 64
A_V_DIM = 2 * A_QK_DIM
A_WIDTH = MIX_WIDTH // 2
A_HEADS = A_WIDTH // A_V_DIM
Q_BLOCK = 128
N_BUCKETS = 32
MAX_EXACT = 16
MAX_DISTANCE = 128
B_WIDTH = MIX_WIDTH - A_WIDTH
B_HEADS = 4
B_VAL_DIM = B_WIDTH // B_HEADS
B_KEY_DIM = B_VAL_DIM // 2
GATE_RANK = 16
GATE_TEMP = 16.0
GLA_CHUNK = 64
IN_AB_SIZES = (A_HEADS * 2 * A_QK_DIM, A_HEADS * 2 * A_QK_DIM, A_WIDTH,
               B_HEADS * B_KEY_DIM, B_HEADS * B_KEY_DIM, B_WIDTH, B_WIDTH, GATE_RANK)
IN_AB = sum(IN_AB_SIZES)
C_WIDTH = D_MODEL
C_GROUPS = 8
C_GROUP_DIM = C_WIDTH // C_GROUPS
C_CHUNK = 128
N_GROUPS = 4
EXPERTS_PER_GROUP = 8
N_EXPERTS = N_GROUPS * EXPERTS_PER_GROUP
TOP_K = 2
EXPERT_FF = D_MODEL // 4
DISPATCH_BLOCK = 128

kernel_name = "hybrid_diffattn_gla_gmlp_hmoe"


def rmsnorm(x, g):
    xf = x.astype(jnp.float32)
    y = xf * lax.rsqrt(jnp.mean(xf * xf, axis=-1, keepdims=True) + EPS)
    return (y * g.astype(jnp.float32)).astype(x.dtype)


def layernorm(x, g, b):
    xf = x.astype(jnp.float32)
    mu = jnp.mean(xf, axis=-1, keepdims=True)
    var = jnp.mean(jnp.square(xf - mu), axis=-1, keepdims=True)
    y = (xf - mu) * lax.rsqrt(var + EPS)
    return (y * g.astype(jnp.float32) + b.astype(jnp.float32)).astype(x.dtype)


def t5_bucket(rel):
    n = jnp.maximum(rel, 0)
    nf = jnp.maximum(n, 1).astype(jnp.float32)
    large = MAX_EXACT + (jnp.log(nf / MAX_EXACT) / math.log(MAX_DISTANCE / MAX_EXACT)
                         * (N_BUCKETS - MAX_EXACT)).astype(jnp.int32)
    large = jnp.minimum(large, N_BUCKETS - 1)
    return jnp.where(n < MAX_EXACT, n, large)


def diff_attention(q, k, v, lam_vec, subln_g, rel_bias, lam_init):
    bsz, s_len = q.shape[0], q.shape[1]
    nb = s_len // Q_BLOCK
    lv = lam_vec.astype(jnp.float32)
    lam = jnp.exp(jnp.sum(lv[0] * lv[1])) - jnp.exp(jnp.sum(lv[2] * lv[3])) + lam_init
    scale = A_QK_DIM ** -0.5
    qb_all = (q.astype(jnp.float32) * scale).reshape(
        bsz, nb, Q_BLOCK, A_HEADS, 2, A_QK_DIM).transpose(1, 0, 3, 4, 2, 5)
    kf = k.astype(jnp.float32).transpose(0, 2, 3, 1, 4)
    vf = v.astype(jnp.float32).transpose(0, 2, 1, 3)
    tbl = rel_bias.astype(jnp.float32)
    k_pos = jnp.arange(s_len, dtype=jnp.int32)

    def block(args):
        qb, i = args
        q_pos = i * Q_BLOCK + jnp.arange(Q_BLOCK, dtype=jnp.int32)
        rel = q_pos[:, None] - k_pos[None, :]
        bias = tbl[t5_bucket(rel)].transpose(2, 0, 1)
        s = jnp.einsum('bhmqd,bhmkd->bhmqk', qb, kf) + bias[None, :, None]
        s = jnp.where((rel >= 0)[None, None, None], s, -jnp.inf)
        p = jax.nn.softmax(s, axis=-1)
        w = p[:, :, 0] - lam * p[:, :, 1]
        return jnp.einsum('bhqk,bhkd->bhqd', w, vf)

    o = lax.map(block, (qb_all, jnp.arange(nb, dtype=jnp.int32)))
    o = o.transpose(1, 0, 3, 2, 4).reshape(bsz, s_len, A_HEADS, A_V_DIM)
    o = rmsnorm(o, subln_g) * (1.0 - lam_init)
    return o.reshape(bsz, s_len, A_WIDTH)


def gla(q, k, v, g_log):
    bsz, s_len = q.shape[0], q.shape[1]
    nc = s_len // GLA_CHUNK

    def to_chunks(t):
        return t.astype(jnp.float32).reshape(
            bsz, nc, GLA_CHUNK, B_HEADS, t.shape[-1]).transpose(1, 0, 3, 2, 4)

    qc = to_chunks(q) * (B_KEY_DIM ** -0.5)
    kc, vc, gc = to_chunks(k), to_chunks(v), to_chunks(g_log)
    causal = jnp.tril(jnp.ones((GLA_CHUNK, GLA_CHUNK), dtype=bool))

    def chunk(state, inp):
        qi, ki, vi, gi = inp
        b = jnp.cumsum(gi, axis=2)
        o_inter = jnp.einsum('bhcd,bhde->bhce', qi * jnp.exp(b), state)
        diff = b[:, :, :, None, :] - b[:, :, None, :, :]
        decay = jnp.exp(jnp.where(causal[None, None, :, :, None], diff, -jnp.inf))
        att = jnp.einsum('bhid,bhjd,bhijd->bhij', qi, ki, decay)
        o_intra = jnp.einsum('bhij,bhje->bhie', att, vi)
        b_last = b[:, :, -1:, :]
        new_state = (jnp.exp(b_last[:, :, 0, :, None]) * state
                     + jnp.einsum('bhjd,bhje->bhde', ki * jnp.exp(b_last - b), vi))
        return new_state, o_inter + o_intra

    s0 = jnp.zeros((bsz, B_HEADS, B_KEY_DIM, B_VAL_DIM), jnp.float32)
    _, o = lax.scan(chunk, s0, (qc, kc, vc, gc))
    return o.transpose(1, 0, 3, 2, 4).reshape(bsz, s_len, B_HEADS, B_VAL_DIM)


def mix_ab(h, w_in, lam_vec, subln_g, w_gk, b_gk, gnorm_g, w_out, rel_bias, lam_init):
    bsz, s_len, _ = h.shape
    proj = h @ w_in
    cuts = [int(c) for c in np.cumsum(IN_AB_SIZES)[:-1]]
    qa, ka, va, qb, kb, vb, rb, gb = jnp.split(proj, cuts, axis=-1)
    o_a = diff_attention(qa.reshape(bsz, s_len, A_HEADS, 2, A_QK_DIM),
                         ka.reshape(bsz, s_len, A_HEADS, 2, A_QK_DIM),
                         va.reshape(bsz, s_len, A_HEADS, A_V_DIM),
                         lam_vec, subln_g, rel_bias, lam_init).astype(h.dtype)
    g_log = jax.nn.log_sigmoid((gb @ w_gk + b_gk).astype(jnp.float32)) / GATE_TEMP
    o_b = gla(qb.reshape(bsz, s_len, B_HEADS, B_KEY_DIM),
              kb.reshape(bsz, s_len, B_HEADS, B_KEY_DIM),
              vb.reshape(bsz, s_len, B_HEADS, B_VAL_DIM),
              g_log.reshape(bsz, s_len, B_HEADS, B_KEY_DIM))
    o_b = rmsnorm(o_b, gnorm_g).reshape(bsz, s_len, B_WIDTH).astype(h.dtype) * jax.nn.silu(rb)
    return jnp.concatenate([o_a, o_b], axis=-1) @ w_out


def mix_c(h, w_in, ln_g, ln_b, w_s, b_s, w_out):
    bsz, s_len, _ = h.shape
    nc = s_len // C_CHUNK
    u, v = jnp.split(jax.nn.gelu(h @ w_in), 2, axis=-1)
    v = layernorm(v, ln_g, ln_b).reshape(bsz, nc, C_CHUNK, C_GROUPS, C_GROUP_DIM)
    ws = jnp.where(jnp.tril(jnp.ones((C_CHUNK, C_CHUNK), dtype=bool))[None], w_s, 0.0)
    z = jnp.einsum('gts,bcsgd->bctgd', ws, v) + b_s.T[None, None, :, :, None]
    return (u * z.reshape(bsz, s_len, C_WIDTH)) @ w_out


def moe_ffn(h, w_rg, w_re, w_gate, w_up, w_down):
    n_tok = h.shape[0]
    grp_prob = jax.nn.softmax((h @ w_rg).astype(jnp.float32), axis=-1)
    p_grp, g_idx = lax.top_k(grp_prob, 1)
    e_logits = (h @ w_re).astype(jnp.float32).reshape(n_tok, N_GROUPS, EXPERTS_PER_GROUP)
    idx = jnp.broadcast_to(g_idx[:, :, None], (n_tok, 1, EXPERTS_PER_GROUP))
    e_logits = jnp.take_along_axis(e_logits, idx, axis=1)[:, 0]
    p_in, e_in = lax.top_k(jax.nn.softmax(e_logits, axis=-1), TOP_K)
    gates = p_grp * p_in / jnp.sum(p_in, axis=-1, keepdims=True)
    expert_id = g_idx * EXPERTS_PER_GROUP + e_in

    n_assign = n_tok * TOP_K
    flat_e = expert_id.reshape(-1).astype(jnp.int32)
    flat_tok = jnp.repeat(jnp.arange(n_tok, dtype=jnp.int32), TOP_K)
    order = jnp.argsort(flat_e)
    se, stok, sgate = flat_e[order], flat_tok[order], gates.reshape(-1)[order]
    counts = jnp.bincount(flat_e, length=N_EXPERTS)
    ends = jnp.cumsum(counts)
    starts = ends - counts
    first_blk = starts // DISPATCH_BLOCK
    last_blk = (ends - 1) // DISPATCH_BLOCK
    n_items = jnp.where(counts > 0, last_blk - first_blk + 1, 0)
    item_end = jnp.cumsum(n_items)
    item_start = item_end - n_items
    n_slots = -(-n_assign // DISPATCH_BLOCK) + N_EXPERTS
    slot = jnp.arange(n_slots, dtype=jnp.int32)
    item_e = jnp.minimum(jnp.searchsorted(item_end, slot, side='right'), N_EXPERTS - 1)
    item_valid = slot < item_end[-1]
    item_blk = first_blk[item_e] + slot - item_start[item_e]
    rows = item_blk[:, None] * DISPATCH_BLOCK + jnp.arange(DISPATCH_BLOCK, dtype=jnp.int32)[None]
    row_ok = item_valid[:, None] & (rows >= 0) & (rows < n_assign)
    rows = jnp.clip(rows, 0, n_assign - 1)
    row_ok = row_ok & (se[rows] == item_e[:, None])
    xs = h[stok]

    def run_item(args):
        e, r, ok = args
        xb = xs[r]
        act = jax.nn.silu(xb @ w_gate[e]) * (xb @ w_up[e])
        return jnp.where(ok[:, None], act @ w_down[e], 0.0).astype(h.dtype)

    y = lax.map(run_item, (item_e, rows, row_ok))
    y_sorted = jnp.zeros_like(xs).at[rows.reshape(-1)].add(y.reshape(-1, D_MODEL))
    return jax.ops.segment_sum(y_sorted * sgate[:, None].astype(h.dtype), stok,
                               num_segments=n_tok)


def setup_inputs(seed: int = 0) -> dict:
    key = jax.random.key(seed)
    ks = jax.random.split(key, 24)

    def nrm(k, shape, scale):
        return jax.random.normal(k, shape, jnp.float32) * scale

    return {
        "x": nrm(ks[0], (BATCH, SEQ, D_MODEL), 1.0),
        "rel_bias": nrm(ks[1], (N_BUCKETS, A_HEADS), 0.5),
        "norm_mix": 1.0 + nrm(ks[2], (DEPTH, D_MODEL), 0.02),
        "norm_ffn": 1.0 + nrm(ks[3], (DEPTH, D_MODEL), 0.02),
        "norm_final": 1.0 + nrm(ks[4], (D_MODEL,), 0.02),
        "w_in_ab": nrm(ks[5], (N_EVEN, D_MODEL, IN_AB), D_MODEL ** -0.5),
        "lam_ab": nrm(ks[6], (N_EVEN, 4, A_QK_DIM), 0.1),
        "subln_ab": 1.0 + nrm(ks[7], (N_EVEN, A_V_DIM), 0.02),
        "w_gk_ab": nrm(ks[8], (N_EVEN, GATE_RANK, B_HEADS * B_KEY_DIM), GATE_RANK ** -0.5),
        "b_gk_ab": nrm(ks[9], (N_EVEN, B_HEADS * B_KEY_DIM), 0.02),
        "gnorm_ab": 1.0 + nrm(ks[10], (N_EVEN, B_VAL_DIM), 0.02),
        "w_out_ab": nrm(ks[11], (N_EVEN, MIX_WIDTH, D_MODEL), MIX_WIDTH ** -0.5),
        "w_in_c": nrm(ks[12], (N_ODD, D_MODEL, 2 * C_WIDTH), D_MODEL ** -0.5),
        "ln_v_g": 1.0 + nrm(ks[13], (N_ODD, C_WIDTH), 0.02),
        "ln_v_b": nrm(ks[14], (N_ODD, C_WIDTH), 0.02),
        "w_spatial": nrm(ks[15], (N_ODD, C_GROUPS, C_CHUNK, C_CHUNK), C_CHUNK ** -0.5),
        "b_spatial": 1.0 + nrm(ks[16], (N_ODD, C_GROUPS, C_CHUNK), 0.02),
        "w_out_c": nrm(ks[17], (N_ODD, C_WIDTH, D_MODEL), C_WIDTH ** -0.5),
        "w_router_group": nrm(ks[18], (DEPTH, D_MODEL, N_GROUPS), D_MODEL ** -0.5),
        "w_router_expert": nrm(ks[19], (DEPTH, D_MODEL, N_EXPERTS), D_MODEL ** -0.5),
        "w_exp_gate": nrm(ks[20], (DEPTH, N_EXPERTS, D_MODEL, EXPERT_FF), D_MODEL ** -0.5),
        "w_exp_up": nrm(ks[21], (DEPTH, N_EXPERTS, D_MODEL, EXPERT_FF), D_MODEL ** -0.5),
        "w_exp_down": nrm(ks[22], (DEPTH, N_EXPERTS, EXPERT_FF, D_MODEL), EXPERT_FF ** -0.5),
    }


def reference(x, rel_bias, norm_mix, norm_ffn, norm_final, w_in_ab, lam_ab, subln_ab,
              w_gk_ab, b_gk_ab, gnorm_ab, w_out_ab, w_in_c, ln_v_g, ln_v_b, w_spatial,
              b_spatial, w_out_c, w_router_group, w_router_expert, w_exp_gate, w_exp_up,
              w_exp_down):
    bsz, s_len, d = x.shape
    for layer in range(DEPTH):
        h = rmsnorm(x, norm_mix[layer])
        i = layer // 2
        if layer % 2 == 0:
            lam_init = 0.8 - 0.6 * math.exp(-0.3 * layer)
            x = x + mix_ab(h, w_in_ab[i], lam_ab[i], subln_ab[i], w_gk_ab[i], b_gk_ab[i],
                           gnorm_ab[i], w_out_ab[i], rel_bias, lam_init)
        else:
            x = x + mix_c(h, w_in_c[i], ln_v_g[i], ln_v_b[i], w_spatial[i], b_spatial[i],
                          w_out_c[i])
        h = rmsnorm(x, norm_ffn[layer]).reshape(bsz * s_len, d)
        x = x + moe_ffn(h, w_router_group[layer], w_router_expert[layer], w_exp_gate[layer],
                        w_exp_up[layer], w_exp_down[layer]).reshape(bsz, s_len, d)
    return rmsnorm(x, norm_final)
```

```cpp
#include <hip/hip_runtime.h>
#include <hip/hip_bf16.h>
#include <cstdio>
#include <cstdint>
#include <cmath>

namespace pg8 {
#define PG8_LAS __attribute__((address_space(3)))
typedef unsigned short bf16_t;
typedef short bf16x8 __attribute__((ext_vector_type(8)));
typedef float f32x4 __attribute__((ext_vector_type(4)));
typedef unsigned u32x4 __attribute__((ext_vector_type(4)));
constexpr int BM = 256, BK = 64, HALF = 128, HTB = HALF * BK * 2  , STAGE_BYTES = 8 * HTB, NXCD = 8, WGM = 8;

__host__ __device__ __forceinline__ int lds_byte(int r, int c) { const int st = (r >> 4) * 2 + (c >> 5), rr = r & 15, cc = c & 31, ob = rr * 64 + cc * 2; return st * 1024 + (ob ^ (((ob >> 9) & 1) << 5)); }
__host__ __device__ __forceinline__ void stage_rc(int b, int& R, int& C) { const int st = b / 1024, sb = b % 1024, swz = sb ^ (((sb >> 9) & 1) << 5); R = (st >> 1) * 16 + swz / 64; C = (st & 1) * 32 + (swz % 64) / 2; }
__host__ __device__ __forceinline__ int perm32(int rho) { const int n = rho >> 4, i = rho & 15; return 8 * (i >> 2) + 4 * n + (i & 3); }

struct Unit { int pm, pn, e, s0, cnt, half; };

__device__ __forceinline__ unsigned cvt_pk_bf16(float lo, float hi) { unsigned r; asm volatile("v_cvt_pk_bf16_f32 %0, %1, %2" : "=v"(r) : "v"(lo), "v"(hi)); return r; }

struct QueueProb {
    static constexpr bool GATHER = false;
    const bf16_t* A; const bf16_t* Bt; int K, nM, nN, per, xcd; unsigned* ctr; volatile PG8_LAS int* slot;
    __device__ void init(const bf16_t* A_, const bf16_t* Bt_, int M, int N, int K_, int xcd_, unsigned* ctr_, volatile PG8_LAS int* slot_) { A = A_; Bt = Bt_; K = K_; nM = M / BM; nN = N / BM; per = nM * nN / NXCD; xcd = xcd_; ctr = ctr_; slot = slot_; }
    __device__ __forceinline__ void prime() const {
        if (threadIdx.x == 0) { slot[0] = (int)__hip_atomic_fetch_add(ctr, 1u, __ATOMIC_RELAXED, __HIP_MEMORY_SCOPE_AGENT); slot[1] = (int)__hip_atomic_fetch_add(ctr, 1u, __ATOMIC_RELAXED, __HIP_MEMORY_SCOPE_AGENT); } }
    __device__ __forceinline__ bool next(int i, Unit& u) const {
        const int j3 = i % 3; const int t = __builtin_amdgcn_readfirstlane(slot[j3]);
        if (i > 0 && threadIdx.x == 0) slot[j3 == 2 ? 0 : j3 + 1] = (int)__hip_atomic_fetch_add(ctr, 1u, __ATOMIC_RELAXED, __HIP_MEMORY_SCOPE_AGENT);
        if (t >= per) return false;
        const int wgid = xcd * per + t;
        const int nig = WGM * nN, gid = wgid / nig, fm = gid * WGM, gsz = (nM - fm) < WGM ? (nM - fm) : WGM;
        u.pm = fm + ((wgid % nig) % gsz); u.pn = (wgid % nig) / gsz; u.e = 0; u.s0 = 0; u.cnt = 0; u.half = 0; return true;
    }
    __device__ __forceinline__ const char* a_base(const Unit& u) const { return (const char*)A + (size_t)u.pm * BM * K * 2; }
    __device__ __forceinline__ const char* b_base(const Unit& u) const { return (const char*)Bt + (size_t)u.pn * BM * K * 2; }
    __device__ __forceinline__ unsigned a_row(const Unit&, int r) const { return (unsigned)r * (unsigned)K * 2u; }
};
struct DenseProb {
    static constexpr bool GATHER = false;
    const bf16_t* A; const bf16_t* Bt; int K, nM, nN, nwg, G, c;
    __device__ void init(const bf16_t* A_, const bf16_t* Bt_, int M, int N, int K_, int G_, int c_) { A = A_; Bt = Bt_; K = K_; nM = M / BM; nN = N / BM; nwg = nM * nN; G = G_; c = c_; }
    __device__ __forceinline__ bool next(int i, Unit& u) const {
        const long L = (long)i * G + c; if (L >= nwg) return false;
        int wgid = (int)L; { const int q = nwg / NXCD, r = nwg % NXCD, xcd = wgid % NXCD, off = wgid / NXCD; wgid = (xcd < r ? xcd * (q + 1) : r * (q + 1) + (xcd - r) * q) + off; }
        const int nig = WGM * nN, gid = wgid / nig, fm = gid * WGM, gsz = (nM - fm) < WGM ? (nM - fm) : WGM;
        u.pm = fm + ((wgid % nig) % gsz); u.pn = (wgid % nig) / gsz; u.e = 0; u.s0 = 0; u.cnt = 0; u.half = 0; return true;
    }
    __device__ __forceinline__ const char* a_base(const Unit& u) const { return (const char*)A + (size_t)u.pm * BM * K * 2; }
    __device__ __forceinline__ const char* b_base(const Unit& u) const { return (const char*)Bt + (size_t)u.pn * BM * K * 2; }
    __device__ __forceinline__ unsigned a_row(const Unit&, int r) const { return (unsigned)r * (unsigned)K * 2u; }
};
__device__ __forceinline__ int xcd_remap(int L, int U) { const int q = U / NXCD, r = U % NXCD, xcd = L % NXCD, off = L / NXCD; return (xcd < r ? xcd * (q + 1) : r * (q + 1) + (xcd - r) * q) + off; }
template <bool GATHER_> struct MoeProb {
    static constexpr bool GATHER = GATHER_;
    const bf16_t* A; const bf16_t* Bt; int K, NPN; size_t bstride;
    int l0, l1, lstride, lcount, U, split_base; bool use_list, split;
    const PG8_LAS int* mt_e; const PG8_LAS int* mt_s0; const PG8_LAS int* cnt; const PG8_LAS int* mlist; const int* list;
    __device__ __forceinline__ bool next(int i, Unit& u) const {
        int L = i == 0 ? l0 : l1 + (i - 1) * lstride; if (i > 64 || L >= lcount) return false;
        u.half = 0; if (split) { u.half = 1 + (L & 1); L = split_base + (L >> 1); }
        if (use_list) { u.pm = mlist[L / NPN]; u.pn = L % NPN; } else { const int w = xcd_remap(L, U); u.pm = w / NPN; u.pn = w % NPN; }
        u.e = mt_e[u.pm]; u.s0 = mt_s0[u.pm]; u.cnt = cnt[u.e]; return true;
    }
    __device__ __forceinline__ const char* a_base(const Unit& u) const { return GATHER ? (const char*)A : (const char*)A + (size_t)u.pm * BM * K * 2; }
    __device__ __forceinline__ const char* b_base(const Unit& u) const { return (const char*)Bt + (size_t)u.e * bstride + (size_t)u.pn * BM * K * 2; }
    __device__ __forceinline__ unsigned a_row(const Unit& u, int r) const {
        if (!GATHER) return (unsigned)r * (unsigned)K * 2u;
        const int slot = u.s0 + r; const int tok = slot < u.cnt ? list[u.e * 8192 + slot] : 0; return (unsigned)tok * (unsigned)K * 2u;
    }
};

struct EpiBf16S {
    static constexpr bool PERM = true;
    bf16_t* O; int ldc; float scale0; int scale_cols;
    __device__ __forceinline__ void operator()(const f32x4 (&acc)[2][2][4][2], const Unit& u, int wr, int wc, int fr, int fq) const {
        const int row0 = u.pm * BM + wr * 64 + fr, colt = u.pn * BM; const float sc = colt < scale_cols ? scale0 : 1.f;
        const int col0 = colt + wc * 32 + 8 * fq;
#pragma unroll
        for (int ai = 0; ai < 2; ++ai) { if (u.half == 2 - ai) continue;
#pragma unroll
            for (int m = 0; m < 4; ++m) { bf16_t* rowp = O + (size_t)(row0 + ai * HALF + m * 16) * ldc + col0;
#pragma unroll
                for (int bj = 0; bj < 2; ++bj) { const f32x4 v0 = acc[ai][bj][m][0] * sc, v1 = acc[ai][bj][m][1] * sc;
                    u32x4 w; w.x = cvt_pk_bf16(v0[0], v0[1]); w.y = cvt_pk_bf16(v0[2], v0[3]); w.z = cvt_pk_bf16(v1[0], v1[1]); w.w = cvt_pk_bf16(v1[2], v1[3]);
                    *(u32x4*)(rowp + bj * HALF) = w; } } }
    }
};
struct EpiBf16M {
    static constexpr bool PERM = true;
    bf16_t* O; int ldc;
    __device__ __forceinline__ void operator()(const f32x4 (&acc)[2][2][4][2], const Unit& u, int wr, int wc, int fr, int fq) const {
        const int row0 = u.pm * BM + wr * 64 + fr, col0 = u.pn * BM + wc * 32 + 8 * fq, left = u.cnt - u.s0 - wr * 64 - fr;
#pragma unroll
        for (int ai = 0; ai < 2; ++ai) { if (u.half == 2 - ai) continue;
#pragma unroll
            for (int m = 0; m < 4; ++m) { if (ai * HALF + m * 16 >= left) continue;
                bf16_t* rowp = O + (size_t)(row0 + ai * HALF + m * 16) * ldc + col0;
#pragma unroll
                for (int bj = 0; bj < 2; ++bj) { const f32x4 v0 = acc[ai][bj][m][0], v1 = acc[ai][bj][m][1];
                    u32x4 w; w.x = cvt_pk_bf16(v0[0], v0[1]); w.y = cvt_pk_bf16(v0[2], v0[3]); w.z = cvt_pk_bf16(v1[0], v1[1]); w.w = cvt_pk_bf16(v1[2], v1[3]);
                    *(u32x4*)(rowp + bj * HALF) = w; } } }
    }
};
struct EpiRes {
    static constexpr bool PERM = false;
    const float* base; float* out; int ldc;
    __device__ __forceinline__ void operator()(const f32x4 (&acc)[2][2][4][2], const Unit& u, int wr, int wc, int fr, int fq) const {
        const int row0 = u.pm * BM + wr * 64 + fr, col0 = u.pn * BM + wc * 32 + 4 * fq;
        f32x4 cur[2][2], nxt[2][2];
#define ER_LOAD(dst, g) do { const size_t off_ = (size_t)(row0 + ((g) >> 2) * HALF + ((g) & 3) * 16) * ldc + col0; \
        _Pragma("unroll") for (int bj = 0; bj < 2; ++bj) _Pragma("unroll") for (int n = 0; n < 2; ++n) dst[bj][n] = *(const f32x4*)(base + off_ + bj * HALF + n * 16); } while (0)
        ER_LOAD(cur, 0);
#pragma unroll
        for (int g = 0; g < 8; ++g) { const int ai = g >> 2, m = g & 3; const size_t off = (size_t)(row0 + ai * HALF + m * 16) * ldc + col0;
            if (g < 7) ER_LOAD(nxt, g + 1);
#pragma unroll
            for (int bj = 0; bj < 2; ++bj)
#pragma unroll
                for (int n = 0; n < 2; ++n) *(f32x4*)(out + off + bj * HALF + n * 16) = cur[bj][n] + acc[ai][bj][m][n];
#pragma unroll
            for (int bj = 0; bj < 2; ++bj)
#pragma unroll
                for (int n = 0; n < 2; ++n) cur[bj][n] = nxt[bj][n];
            asm volatile("" ::: "memory"); }
#undef ER_LOAD
    }
};
__device__ __forceinline__ float gelu_tanh(float x) {
    const float u2 = x * (1.5957691216057308f + 0.07135481282052917f * x * x);
    return x * __builtin_amdgcn_rcpf(1.0f + __builtin_amdgcn_exp2f(-1.4426950408889634f * u2));
}
struct EpiGelu {
    static constexpr bool PERM = true;
    bf16_t* O; int ldc; float* stats; int stat_col0;
    __device__ __forceinline__ void operator()(const f32x4 (&acc)[2][2][4][2], const Unit& u, int wr, int wc, int fr, int fq) const {
        const int row0 = u.pm * BM + wr * 64 + fr, colt = u.pn * BM; const bool st = colt >= stat_col0;
        const int col0 = colt + wc * 32 + 8 * fq;
#pragma unroll
        for (int ai = 0; ai < 2; ++ai)
#pragma unroll
            for (int m = 0; m < 4; ++m) { const int row = row0 + ai * HALF + m * 16; bf16_t* rowp = O + (size_t)row * ldc + col0; float s1 = 0.f, s2 = 0.f;
#pragma unroll
                for (int bj = 0; bj < 2; ++bj) { f32x4 v0 = acc[ai][bj][m][0], v1 = acc[ai][bj][m][1];
#pragma unroll
                    for (int j = 0; j < 4; ++j) { v0[j] = gelu_tanh(v0[j]); v1[j] = gelu_tanh(v1[j]); s1 += v0[j] + v1[j]; s2 += v0[j] * v0[j] + v1[j] * v1[j]; }
                    u32x4 w; w.x = cvt_pk_bf16(v0[0], v0[1]); w.y = cvt_pk_bf16(v0[2], v0[3]); w.z = cvt_pk_bf16(v1[0], v1[1]); w.w = cvt_pk_bf16(v1[2], v1[3]);
                    *(u32x4*)(rowp + bj * HALF) = w; }
                if (st) { s1 += __shfl_xor(s1, 16); s1 += __shfl_xor(s1, 32); s2 += __shfl_xor(s2, 16); s2 += __shfl_xor(s2, 32);
                    if (fq == 0) { typedef float f32x2s __attribute__((ext_vector_type(2))); *(f32x2s*)(stats + ((size_t)row * 32 + ((colt - stat_col0) >> 8) * 4 + wc) * 2) = (f32x2s){s1, s2}; } } }
    }
};
struct EpiSwiglu {
    static constexpr bool PERM = true;
    bf16_t* O; int ldc; unsigned* done;
    __device__ __forceinline__ void operator()(const f32x4 (&acc)[2][2][4][2], const Unit& u, int wr, int wc, int fr, int fq) const {
        const int row0 = u.pm * BM + wr * 64 + fr, col0 = u.pn * HALF + wc * 32 + 8 * fq;
        const __amdgpu_buffer_rsrc_t rsrc = __builtin_amdgcn_make_buffer_rsrc(O, 0, 24576 * 512 * 2, 0x00020000);
#pragma unroll
        for (int ai = 0; ai < 2; ++ai) { if (u.half == 2 - ai) continue;
#pragma unroll
            for (int m = 0; m < 4; ++m) { const unsigned boff = (unsigned)((row0 + ai * HALF + m * 16) * ldc + col0) * 2u; f32x4 r[2];
#pragma unroll
                for (int n = 0; n < 2; ++n)
#pragma unroll
                    for (int j = 0; j < 4; ++j) { const float g = acc[ai][0][m][n][j], up = acc[ai][1][m][n][j];
                        r[n][j] = g * __builtin_amdgcn_rcpf(1.0f + __builtin_amdgcn_exp2f(-1.4426950408889634f * g)) * up; }
                u32x4 w; w.x = cvt_pk_bf16(r[0][0], r[0][1]); w.y = cvt_pk_bf16(r[0][2], r[0][3]); w.z = cvt_pk_bf16(r[1][0], r[1][1]); w.w = cvt_pk_bf16(r[1][2], r[1][3]);
                __builtin_amdgcn_raw_buffer_store_b128(w, rsrc, (int)boff, 0,   16); } }
        asm volatile("s_waitcnt vmcnt(0)" ::: "memory");
        if (fr == 0 && fq == 0) __hip_atomic_fetch_add(done + u.pm * 8, 1u, __ATOMIC_RELAXED, __HIP_MEMORY_SCOPE_AGENT);
    }
};

template <class Epi, class Prob, bool ALIGN_EPI, int HM = 0>
__device__ __forceinline__ void gemm_phase(PG8_LAS unsigned char* lds, const Prob& P, const Epi& E) {
    int tid_ = threadIdx.x; asm volatile("" : "+v"(tid_));
    const int tid = tid_, wid = __builtin_amdgcn_readfirstlane(tid >> 6), lane = tid & 63, wr = wid >> 2, wc = wid & 3, fr = lane & 15, fq = lane >> 4;
    const int K = P.K, nt = K / BK;
    int R0, C0, R1, C1; stage_rc(tid * 16, R0, C0); stage_rc(tid * 16 + 8192, R1, C1);
    const int Rb0 = Epi::PERM ? ((R0 & ~31) + perm32(R0 & 31)) : R0, Rb1 = Epi::PERM ? ((R1 & ~31) + perm32(R1 & 31)) : R1;
    const unsigned voffB0 = (unsigned)(Rb0 * K + C0) * 2u, voffB1 = (unsigned)(Rb1 * K + C1) * 2u;
    const unsigned colA0 = (unsigned)C0 * 2u, colA1 = (unsigned)C1 * 2u;
    const size_t kstep = (size_t)(BK * 2);
    const size_t hstep = (size_t)HALF * K * 2;
    const unsigned ldsw = (unsigned)wid * 1024u;
    const int aoff = lds_byte(wr * 64 + fr, fq * 8), boff = lds_byte(wc * 32 + fr, fq * 8);
#define PG8_SA(b, h) (((b) * 2 + (h)) * HTB)
#define PG8_SB(b, h) ((4 + (b) * 2 + (h)) * HTB)
#define PG8_STAGE2(bufoff, gbase, o0, o1) do { \
        __builtin_amdgcn_global_load_lds((const unsigned*)((const char*)(gbase) + (o0)), (PG8_LAS unsigned*)(lds + (bufoff) + ldsw), 16, 0, 0); \
        __builtin_amdgcn_global_load_lds((const unsigned*)((const char*)(gbase) + (o1)), (PG8_LAS unsigned*)(lds + (bufoff) + ldsw + 8192), 16, 0, 0); } while (0)
#define PG8_STAGEB(bufoff, gbase) PG8_STAGE2(bufoff, gbase, voffB0, voffB1)
#define PG8_LDA(dst, b, h) do { _Pragma("unroll") for (int m = 0; m < 4; ++m) _Pragma("unroll") for (int k = 0; k < 2; ++k) dst[m][k] = *(const PG8_LAS bf16x8*)(lds + PG8_SA(b, h) + aoff + m * 2048 + k * 1024); } while (0)
#define PG8_LDB(dst, b, h) do { _Pragma("unroll") for (int n = 0; n < 2; ++n) _Pragma("unroll") for (int k = 0; k < 2; ++k) dst[n][k] = *(const PG8_LAS bf16x8*)(lds + PG8_SB(b, h) + boff + n * 2048 + k * 1024); } while (0)
#define PG8_MMA(ai, bj, At, Bt) do { __builtin_amdgcn_s_setprio(1); _Pragma("unroll") for (int m = 0; m < 4; ++m) _Pragma("unroll") for (int n = 0; n < 2; ++n) _Pragma("unroll") for (int k = 0; k < 2; ++k) \
        acc[ai][bj][m][n] = __builtin_amdgcn_mfma_f32_16x16x32_bf16(Bt[n][k], At[m][k], acc[ai][bj][m][n], 0, 0, 0); __builtin_amdgcn_s_setprio(0); } while (0)
#define PG8_WAIT_V(n) asm volatile("s_waitcnt vmcnt(" #n ")" ::: "memory")
#define PG8_WAIT_L(n) asm volatile("s_waitcnt lgkmcnt(" #n ")" ::: "memory")
#define PG8_BAR __builtin_amdgcn_s_barrier()
#define PG8_SCHED __builtin_amdgcn_sched_barrier(0)
    Unit cur, nxt; int ui = 0;
    if (!P.next(0, cur)) return;
    f32x4 acc[2][2][4][2];
#pragma unroll
    for (int a = 0; a < 2; ++a)
#pragma unroll
        for (int b = 0; b < 2; ++b)
#pragma unroll
            for (int m = 0; m < 4; ++m)
#pragma unroll
                for (int n = 0; n < 2; ++n) acc[a][b][m][n] = (f32x4){0.f, 0.f, 0.f, 0.f};
    bf16x8 At[4][2], B0[2][2], B1[2][2];
    const char* cA = P.a_base(cur); const char* cB = P.b_base(cur);
    unsigned cv00 = P.a_row(cur, R0) + colA0, cv01 = P.a_row(cur, R1) + colA1, cv10 = P.a_row(cur, HALF + R0) + colA0, cv11 = P.a_row(cur, HALF + R1) + colA1;
    PG8_STAGEB(PG8_SB(0, 0), cB); PG8_STAGEB(PG8_SB(0, 1), cB + hstep); PG8_STAGE2(PG8_SA(0, 0), cA, cv00, cv01); PG8_STAGE2(PG8_SA(0, 1), cA, cv10, cv11);
    if (wr == 1) PG8_BAR;
    PG8_WAIT_V(2); PG8_BAR;
    PG8_STAGEB(PG8_SB(1, 0), cB + kstep); PG8_STAGE2(PG8_SA(1, 0), cA + kstep, cv00, cv01); PG8_STAGEB(PG8_SB(1, 1), cB + hstep + kstep);
    PG8_WAIT_V(6); PG8_BAR;
    for (;;) {
        const bool has_next = P.next(ui + 1, nxt);
        const char* nA = has_next ? P.a_base(nxt) : cA; const char* nB = has_next ? P.b_base(nxt) : cB;
        unsigned nv00 = cv00, nv01 = cv01, nv10 = cv10, nv11 = cv11;
        if (Prob::GATHER && has_next) { nv00 = P.a_row(nxt, R0) + colA0; nv01 = P.a_row(nxt, R1) + colA1; nv10 = P.a_row(nxt, HALF + R0) + colA0; nv11 = P.a_row(nxt, HALF + R1) + colA1; }
        constexpr bool DO0 = HM != 2, DO1 = HM != 1;
        for (int t = 0; t < nt; t += 2) {
            const bool last = (t == nt - 2);
            const char* a1 = cA + (size_t)(t + 1) * kstep;
            const char* a2 = last ? nA : cA + (size_t)(t + 2) * kstep; const char* b2 = last ? nB : cB + (size_t)(t + 2) * kstep;
            const char* a3 = a2 + kstep; const char* b3 = b2 + kstep;
            const unsigned s00 = (Prob::GATHER && last) ? nv00 : cv00, s01 = (Prob::GATHER && last) ? nv01 : cv01, s10 = (Prob::GATHER && last) ? nv10 : cv10, s11 = (Prob::GATHER && last) ? nv11 : cv11;
            PG8_LDB(B0, 0, 0); PG8_LDB(B1, 0, 1); PG8_SCHED; if (DO0) PG8_LDA(At, 0, 0); PG8_STAGE2(PG8_SA(1, 1), a1, cv10, cv11);
            PG8_WAIT_V(8); PG8_WAIT_L(0); PG8_BAR; if (DO0) { PG8_MMA(0, 0, At, B0); PG8_MMA(0, 1, At, B1); } PG8_BAR; PG8_SCHED;
            if (DO1) PG8_LDA(At, 0, 1); PG8_STAGEB(PG8_SB(0, 0), b2); PG8_STAGEB(PG8_SB(0, 1), b2 + hstep); PG8_STAGE2(PG8_SA(0, 0), a2, s00, s01);
            PG8_WAIT_V(8); PG8_WAIT_L(0); PG8_BAR; if (DO1) { PG8_MMA(1, 0, At, B0); PG8_MMA(1, 1, At, B1); } PG8_BAR; PG8_SCHED;
            PG8_LDB(B0, 1, 0); PG8_LDB(B1, 1, 1); PG8_SCHED; if (DO0) PG8_LDA(At, 1, 0); PG8_STAGE2(PG8_SA(0, 1), a2, s10, s11);
            PG8_WAIT_V(8); PG8_WAIT_L(0); PG8_BAR; if (DO0) { PG8_MMA(0, 0, At, B0); PG8_MMA(0, 1, At, B1); } PG8_BAR; PG8_SCHED;
            if (DO1) PG8_LDA(At, 1, 1); PG8_STAGEB(PG8_SB(1, 0), b3); PG8_STAGEB(PG8_SB(1, 1), b3 + hstep); PG8_STAGE2(PG8_SA(1, 0), a3, s00, s01);
            PG8_WAIT_V(8); PG8_WAIT_L(0); PG8_BAR; if (DO1) { PG8_MMA(1, 0, At, B0); PG8_MMA(1, 1, At, B1); } PG8_BAR; PG8_SCHED;
        }
        if constexpr (ALIGN_EPI) { if (wr == 0) PG8_BAR; }
        E(acc, cur, wr, wc, fr, fq);
        if (!has_next) break;
#pragma unroll
        for (int a = 0; a < 2; ++a)
#pragma unroll
            for (int b = 0; b < 2; ++b)
#pragma unroll
                for (int m = 0; m < 4; ++m)
#pragma unroll
                    for (int n = 0; n < 2; ++n) acc[a][b][m][n] = (f32x4){0.f, 0.f, 0.f, 0.f};
        cur = nxt; cA = nA; cB = nB; ++ui; cv00 = nv00; cv01 = nv01; cv10 = nv10; cv11 = nv11;
        if constexpr (ALIGN_EPI) { if (wr == 1) PG8_BAR; }
    }
    PG8_WAIT_V(0);
    if constexpr (!ALIGN_EPI) { if (wr == 0) PG8_BAR; }
    PG8_BAR;
#undef PG8_SA
#undef PG8_SB
#undef PG8_STAGE2
#undef PG8_STAGEB
#undef PG8_LDA
#undef PG8_LDB
#undef PG8_MMA
#undef PG8_WAIT_V
#undef PG8_WAIT_L
#undef PG8_BAR
#undef PG8_SCHED
}
}
namespace attn_body {
using bf16=__hip_bfloat16;
using bf16x8=__attribute__((ext_vector_type(8)))short;
using s16x4=__attribute__((ext_vector_type(4)))short;
using f32x16=__attribute__((ext_vector_type(16)))float;
using u32x4=__attribute__((ext_vector_type(4)))unsigned;
constexpr int SEQ=4096,D=64,PQ=6144,PO=2048;
constexpr int NW=8,QBLK=32,QB=QBLK*NW,KVBLK=64,NQB=SEQ/QB;
__device__ __forceinline__ int crow(int r,int hi){return (r&3)+8*(r>>2)+4*hi;}
#define SBAR() __builtin_amdgcn_sched_barrier(0)
typedef __attribute__((address_space(3))) const float* lds_cfptr;
__device__ __forceinline__ void cmask(f32x16&p0,f32x16&p1,int jb,int qrel,int hi,lds_cfptr tab){
  const float NEG=-INFINITY; const int rb=qrel-64*jb-4*hi;
  #pragma unroll
  for(int g=0;g<4;++g){
    #pragma unroll
    for(int q=0;q<4;++q){const int r=4*g+q; const int rel0=rb-(q+8*g), rel1=rel0-32;
      const int i0=rel0<0?0:(rel0>127?127:rel0), i1=rel1<0?0:(rel1>127?127:rel1);
      const float b0=tab[i0], b1=tab[i1];
      p0[r]=rel0<0?NEG:p0[r]+b0; p1[r]=rel1<0?NEG:p1[r]+b1;}
    asm volatile("":"+v"(p0),"+v"(p1)); SBAR();
  }
}

constexpr int NSLOT=3, SLOTB=8192;
constexpr int LDS_K=0, LDS_V=NSLOT*SLOTB, LDS_WS=2*NSLOT*SLOTB, LDS_OST=LDS_WS+NW*64*4, LDS_TAB=LDS_OST+NW*4096, LDS_BYTES=LDS_TAB+512;
constexpr float C2=0.125f*1.4426950408889634f;
__device__ __forceinline__ void glds16(const void*gsrc,unsigned lds_dst){unsigned keep;
  asm volatile("s_mov_b32 %0, m0\n\ts_mov_b32 m0, %2\n\ts_nop 0\n\tglobal_load_lds_dwordx4 %1, off\n\ts_mov_b32 m0, %0":"=&s"(keep):"v"(gsrc),"s"(lds_dst):"memory");}
__device__ __forceinline__ float max3f(float a,float b,float c){float r;asm("v_max3_f32 %0, %1, %2, %3":"=v"(r):"v"(a),"v"(b),"v"(c));return r;}
__device__ __forceinline__ float max2f(float a,float b){float r;asm("v_max_f32_e32 %0, %1, %2":"=v"(r):"v"(a),"v"(b));return r;}
__device__ __forceinline__ float fadd_s(float a,float b){float r;asm("v_add_f32_e32 %0, %1, %2":"=v"(r):"v"(a),"v"(b));return r;}
__device__ __forceinline__ float fsub_s(float a,float b){float r;asm("v_sub_f32_e32 %0, %1, %2":"=v"(r):"v"(a),"v"(b));return r;}
typedef float f32x2_t __attribute__((ext_vector_type(2))); typedef __bf16 bf16x2_t __attribute__((ext_vector_type(2)));
__device__ __forceinline__ unsigned cvtpk_s(float lo,float hi){f32x2_t v={lo,hi};bf16x2_t b=__builtin_convertvector(v,bf16x2_t);return __builtin_bit_cast(unsigned,b);}
#define WAIT_BAR(N) asm volatile("s_waitcnt vmcnt(" #N ") lgkmcnt(0)\n\ts_barrier":::"memory")

__device__ __forceinline__ void qkt(f32x16&p0,f32x16&p1,const char*Kslot,const bf16x8*qr,const f32x16&negm,int r32,int hi){
  const char*kb=Kslot+hi*1024+r32*16;
  #pragma unroll
  for(int d0=0;d0<4;++d0){
    const bf16x8 b0=*reinterpret_cast<const bf16x8*>(kb+d0*2048);
    const bf16x8 b1=*reinterpret_cast<const bf16x8*>(kb+d0*2048+512);
    if(d0==0){p0=__builtin_amdgcn_mfma_f32_32x32x16_bf16(b0,qr[0],negm,0,0,0);p1=__builtin_amdgcn_mfma_f32_32x32x16_bf16(b1,qr[0],negm,0,0,0);}
    else{p0=__builtin_amdgcn_mfma_f32_32x32x16_bf16(b0,qr[d0],p0,0,0,0);p1=__builtin_amdgcn_mfma_f32_32x32x16_bf16(b1,qr[d0],p1,0,0,0);}}
}
typedef __attribute__((address_space(3))) const char* lds_cptr;
typedef short v4i16_t __attribute__((ext_vector_type(4)));
__device__ __forceinline__ void kload8(bf16x8*kf,lds_cptr kp){
  kf[0]=*(const __attribute__((address_space(3))) bf16x8*)(kp);      kf[1]=*(const __attribute__((address_space(3))) bf16x8*)(kp+512);
  kf[2]=*(const __attribute__((address_space(3))) bf16x8*)(kp+2048); kf[3]=*(const __attribute__((address_space(3))) bf16x8*)(kp+2560);
  kf[4]=*(const __attribute__((address_space(3))) bf16x8*)(kp+4096); kf[5]=*(const __attribute__((address_space(3))) bf16x8*)(kp+4608);
  kf[6]=*(const __attribute__((address_space(3))) bf16x8*)(kp+6144); kf[7]=*(const __attribute__((address_space(3))) bf16x8*)(kp+6656);
}
__device__ __forceinline__ void kload2(bf16x8*kf,lds_cptr kp,int j){ kf[2*j]=*(const __attribute__((address_space(3))) bf16x8*)(kp+j*2048); kf[2*j+1]=*(const __attribute__((address_space(3))) bf16x8*)(kp+j*2048+512); }
__device__ __forceinline__ s16x4 vtr(lds_cptr p){ return __builtin_bit_cast(s16x4,__builtin_amdgcn_ds_read_tr16_b64_v4i16((__attribute__((address_space(3))) v4i16_t*)p)); }
__device__ __forceinline__ float rowmax(const f32x16&p0,const f32x16&p1){
  float a=max3f(p0[0],p0[1],p1[0]),b=max3f(p0[2],p0[3],p1[1]);a=max3f(a,p1[2],p1[3]);
  #pragma unroll
  for(int r=4;r<16;r+=4){a=max3f(a,p0[r],p0[r+1]);b=max3f(b,p0[r+2],p0[r+3]);a=max3f(a,p1[r],p1[r+1]);b=max3f(b,p1[r+2],p1[r+3]);}
  const float m=max2f(a,b);
  auto rr=__builtin_amdgcn_permlane32_swap(__float_as_uint(m),__float_as_uint(m),false,false);
  return max2f(__uint_as_float(rr[0]),__uint_as_float(rr[1]));
}
__device__ __forceinline__ void pv(f32x16*o,int vb,bf16x8 pa0,bf16x8 pa1,bf16x8 pa2,bf16x8 pa3){
  #pragma unroll
  for(int d0=0;d0<2;++d0){s16x4 lo[4],hi[4];
    #pragma unroll
    for(int ks=0;ks<4;++ks){
      asm volatile("ds_read_b64_tr_b16 %0,%1 offset:%c2":"=&v"(lo[ks]):"v"(vb),"i"(d0*4096+ks*1024):"memory");
      asm volatile("ds_read_b64_tr_b16 %0,%1 offset:%c2":"=&v"(hi[ks]):"v"(vb),"i"(d0*4096+ks*1024+512):"memory");}
    asm volatile("s_waitcnt lgkmcnt(0)":::"memory");SBAR();
    #define PK(k) (bf16x8){lo[k][0],lo[k][1],lo[k][2],lo[k][3],hi[k][0],hi[k][1],hi[k][2],hi[k][3]}
    o[d0]=__builtin_amdgcn_mfma_f32_32x32x16_bf16(pa0,PK(0),o[d0],0,0,0);
    o[d0]=__builtin_amdgcn_mfma_f32_32x32x16_bf16(pa1,PK(1),o[d0],0,0,0);
    o[d0]=__builtin_amdgcn_mfma_f32_32x32x16_bf16(pa2,PK(2),o[d0],0,0,0);
    o[d0]=__builtin_amdgcn_mfma_f32_32x32x16_bf16(pa3,PK(3),o[d0],0,0,0);
    #undef PK
  }
}

#ifndef ATTN_STORE16
#define ATTN_STORE16(p,v) (*(u32x4*)(p)=(v))
#endif
template<int THRL> __device__ __forceinline__ void attn_unit(int qb,const bf16*Qh,const bf16*__restrict__ Kh,const bf16*__restrict__ Vh,bf16*Oh,char*shm){
  const int tid=threadIdx.x,lane=tid&63,r32=lane&31,hi=lane>>5; const int wid=__builtin_amdgcn_readfirstlane(tid>>6);
  const int q0=qb*QB;
  const bf16*Qw=Qh+(long)(q0+wid*QBLK)*PQ;
  const unsigned lds0=(unsigned)(uintptr_t)shm;
  float*wsf=(float*)(shm+LDS_WS)+wid*64;
  const bf16*ksrc=Kh+(long)lane*PQ+wid*8;
  const bf16*vsrc=Vh+(long)(16*(wid&3)+(lane>>2))*PQ+(wid>>2)*32+(lane&3)*8;
  const unsigned kdst=lds0+LDS_K+wid*1024, vdst=lds0+LDS_V+wid*1024;
  #define DMA_K(t,slot) glds16(ksrc+(long)(t)*KVBLK*PQ,(unsigned)__builtin_amdgcn_readfirstlane(kdst+(slot)))
  #define DMA_V(t,slot) glds16(vsrc+(long)(t)*KVBLK*PQ,(unsigned)__builtin_amdgcn_readfirstlane(vdst+(slot)))
  const int vb0=(int)(lds0+LDS_V)+((lane>>4)&1)*32+(lane&3)*8+(4*hi+((lane&15)>>2))*64;
  const char*Kbase=shm+LDS_K; bf16x8 kf[8];
  const lds_cptr shm3=(lds_cptr)shm; const lds_cptr kp0=shm3+LDS_K+hi*1024+r32*16; const lds_cptr vp0=shm3+LDS_V+((lane>>4)&1)*32+(lane&3)*8+(4*hi+((lane&15)>>2))*64;
  const int NT=(q0+QB)/KVBLK;
  DMA_K(0,0);DMA_V(0,0);DMA_K(1,SLOTB);
  bf16x8 qr[4];
  #pragma unroll
  for(int d0=0;d0<4;++d0)qr[d0]=*reinterpret_cast<const bf16x8*>(&Qw[(long)r32*PQ+d0*16+hi*8]);
  float mhat=0.f,l_reg=0.f;f32x16 o[2];o[0]=f32x16{};o[1]=f32x16{};f32x16 negm=f32x16{};asm volatile("":"+v"(negm));
  const int qrel=wid*QBLK+r32;
  const lds_cfptr tab=(lds_cfptr)((lds_cptr)shm+LDS_TAB);
  #define CMASK(P0,P1,t) do{int jb_=(t)-(NT-4); if(jb_>=-2)cmask(P0,P1,jb_,qrel,hi,tab);}while(0)
  bool resc=false;
  #define START(P0,P1) do{ const float rm=rowmax(P0,P1); resc=false; \
    { const float dl=rm; mhat=fadd_s(mhat,dl); \
      _Pragma("unroll") for(int r=0;r<16;++r){P0[r]=fsub_s(P0[r],dl);P1[r]=fsub_s(P1[r],dl);} \
      _Pragma("unroll") for(int r=0;r<16;++r)negm[r]=-mhat; asm volatile("":"+v"(negm)); } \
    _Pragma("unroll") for(int r=0;r<16;++r)P0[r]=__builtin_amdgcn_exp2f(P0[r]); }while(0)
  #define RESC() do{ if(resc){ asm volatile("s_waitcnt lgkmcnt(0)":::"memory"); \
      _Pragma("unroll") for(int d_=0;d_<2;++d_) _Pragma("unroll") for(int r=0;r<16;++r)o[d_][r]*=wsf[crow(r,hi)]; } }while(0)
  f32x16 pA0,pA1,pB0,pB1;
  int sl_prev=0,sl_cur=0,sl_next=SLOTB;
  #define ROT() do{sl_prev=sl_cur;sl_cur=sl_next;sl_next=(sl_next==(NSLOT-1)*SLOTB)?0:sl_next+SLOTB;}while(0)
  DMA_K(2,2*SLOTB);
  WAIT_BAR(3);
  qkt(pA0,pA1,Kbase,qr,negm,r32,hi);asm volatile("s_nop 15\n\ts_nop 7":"+v"(pA0),"+v"(pA1));CMASK(pA0,pA1,0);
  START(pA0,pA1);
  _Pragma("unroll") for(int r=0;r<16;++r)pA1[r]=__builtin_amdgcn_exp2f(pA1[r]);
  WAIT_BAR(0);
  DMA_K(3,0);DMA_V(1,SLOTB);
  ROT();
  kload8(kf,kp0+sl_cur);
  WAIT_BAR(2);
  s16x4 vlo[8],vhi[8]; u32x4 pw0,pw1,pw2,pw3;
  #define PKW(P,B) cvtpk_s(P[B],P[B+1])
  #define PAF(k) __builtin_bit_cast(bf16x8,pw##k)
  #define VFR(i) (bf16x8){vlo[i][0],vlo[i][1],vlo[i][2],vlo[i][3],vhi[i][0],vhi[i][1],vhi[i][2],vhi[i][3]}
  #define PIN(x) asm volatile("":"+v"(x))
  #define MX3(a,b,c) __builtin_fmaxf(__builtin_fmaxf((a),(b)),(c))
  #define GAPA(MF,A0,A1,A2,A3,W0,W1,PW) do{ MF; sacc+=A0; sacc+=A1; sacc+=A2; sacc+=A3; PIN(sacc); W0; W1; PIN(PW); SBAR(); }while(0)
  #define EX(v) __builtin_amdgcn_exp2f(v)
  #define GAPB(MF,X,B) do{ MF; X[B]=EX(X[B]); X[B+1]=EX(X[B+1]); X[B+2]=EX(X[B+2]); X[B+3]=EX(X[B+3]); PIN(X); SBAR(); }while(0)
  #define VRD(i) do{ vlo[i]=vtr(vp_+(((i)>>2)*4096+((i)&3)*1024)); vhi[i]=vtr(vp_+(((i)>>2)*4096+((i)&3)*1024+512)); }while(0)
  #define KRD(G,j) do{ if(G){ kload2(kf,kp0+sl_next,j); SBAR(); } }while(0)
  #define STEP(C0,C1,P0,P1,t,GK,GV,GL) do{ SBAR(); \
    const lds_cptr vp_=vp0+sl_prev; \
    VRD(0); SBAR(); float sacc=(P0[0]+P0[1]); \
    GAPA(C0=__builtin_amdgcn_mfma_f32_32x32x16_bf16(kf[0],qr[0],negm,0,0,0), P0[2],P0[3],P0[4],P0[5],     pw0[0]=PKW(P0,0), pw0[1]=PKW(P0,2), pw0); \
    VRD(4); SBAR(); GAPA(C1=__builtin_amdgcn_mfma_f32_32x32x16_bf16(kf[1],qr[0],negm,0,0,0), P0[6],P0[7],P0[8],P0[9],     pw0[2]=PKW(P0,4), pw0[3]=PKW(P0,6), pw0); \
    VRD(1); SBAR(); GAPA(C0=__builtin_amdgcn_mfma_f32_32x32x16_bf16(kf[2],qr[1],C0,0,0,0),   P0[10],P0[11],P0[12],P0[13], pw1[0]=PKW(P0,8), pw1[1]=PKW(P0,10), pw1); \
    VRD(5); SBAR(); GAPA(C1=__builtin_amdgcn_mfma_f32_32x32x16_bf16(kf[3],qr[1],C1,0,0,0),   P0[14],P0[15],P1[0],P1[1],   pw1[2]=PKW(P0,12),pw1[3]=PKW(P0,14), pw1); \
    VRD(2); SBAR(); GAPA(C0=__builtin_amdgcn_mfma_f32_32x32x16_bf16(kf[4],qr[2],C0,0,0,0),   P1[2],P1[3],P1[4],P1[5],     pw2[0]=PKW(P1,0), pw2[1]=PKW(P1,2), pw2); \
    VRD(6); SBAR(); GAPA(C1=__builtin_amdgcn_mfma_f32_32x32x16_bf16(kf[5],qr[2],C1,0,0,0),   P1[6],P1[7],P1[8],P1[9],     pw2[2]=PKW(P1,4), pw2[3]=PKW(P1,6), pw2); \
    VRD(3); SBAR(); GAPA(C0=__builtin_amdgcn_mfma_f32_32x32x16_bf16(kf[6],qr[3],C0,0,0,0),   P1[10],P1[11],P1[12],P1[13], pw3[0]=PKW(P1,8), pw3[1]=PKW(P1,10), pw3); \
    VRD(7); SBAR(); GAPA(C1=__builtin_amdgcn_mfma_f32_32x32x16_bf16(kf[7],qr[3],C1,0,0,0),   P1[14],P1[15],0.f,0.f,       pw3[2]=PKW(P1,12),pw3[3]=PKW(P1,14), pw3); \
    l_reg+=sacc; \
    if(GK){DMA_K((t)+3,sl_cur);} if(GV){DMA_V((t)+1,sl_next);} \
    CMASK(C0,C1,t); \
    { float a=MX3(C0[0],C0[1],C1[0]),b=MX3(C0[2],C0[3],C1[1]); a=MX3(a,C1[2],C1[3]); \
      _Pragma("unroll") for(int r=4;r<16;r+=4){a=MX3(a,C0[r],C0[r+1]);b=MX3(b,C0[r+2],C0[r+3]);a=MX3(a,C1[r],C1[r+1]);b=MX3(b,C1[r+2],C1[r+3]);} \
      float rm=__builtin_fmaxf(a,b); { auto rr=__builtin_amdgcn_permlane32_swap(__float_as_uint(rm),__float_as_uint(rm),false,false); rm=__builtin_fmaxf(__uint_as_float(rr[0]),__uint_as_float(rr[1])); } \
      resc=false; \
      if(__builtin_expect(__any(rm>(float)THRL),0)){ const float dl=__builtin_fmaxf(rm,0.f); mhat+=dl; \
        _Pragma("unroll") for(int r=0;r<16;++r){C0[r]-=dl;C1[r]-=dl;} \
        _Pragma("unroll") for(int r=0;r<16;++r)negm[r]=-mhat; asm volatile("":"+v"(negm)); \
        const float f=__builtin_amdgcn_exp2f(-dl); l_reg*=f; if(hi==0)wsf[r32]=f; resc=true; } } \
    SBAR(); \
    GAPB(o[0]=__builtin_amdgcn_mfma_f32_32x32x16_bf16(PAF(0),VFR(0),o[0],0,0,0), C0,0); \
    GAPB(o[1]=__builtin_amdgcn_mfma_f32_32x32x16_bf16(PAF(0),VFR(4),o[1],0,0,0), C0,4); \
    KRD(GL,0); GAPB(o[0]=__builtin_amdgcn_mfma_f32_32x32x16_bf16(PAF(1),VFR(1),o[0],0,0,0), C0,8); \
    KRD(GL,1); GAPB(o[1]=__builtin_amdgcn_mfma_f32_32x32x16_bf16(PAF(1),VFR(5),o[1],0,0,0), C0,12); \
    KRD(GL,2); GAPB(o[0]=__builtin_amdgcn_mfma_f32_32x32x16_bf16(PAF(2),VFR(2),o[0],0,0,0), C1,0); \
    KRD(GL,3); GAPB(o[1]=__builtin_amdgcn_mfma_f32_32x32x16_bf16(PAF(2),VFR(6),o[1],0,0,0), C1,4); \
    GAPB(o[0]=__builtin_amdgcn_mfma_f32_32x32x16_bf16(PAF(3),VFR(3),o[0],0,0,0), C1,8); \
    GAPB(o[1]=__builtin_amdgcn_mfma_f32_32x32x16_bf16(PAF(3),VFR(7),o[1],0,0,0), C1,12); \
    }while(0)
  int t=1;
  #undef CMASK
  #define CMASK(P0,P1,t) do{}while(0)
  for(;t+7<NT;t+=2){
    STEP(pB0,pB1,pA0,pA1,t,true,true,true);     WAIT_BAR(2); RESC(); ROT();
    STEP(pA0,pA1,pB0,pB1,t+1,true,true,true);   WAIT_BAR(2); RESC(); ROT();
  }
  #undef CMASK
  #define CMASK(P0,P1,t) do{int jb_=(t)-(NT-4); if(jb_>=-2)cmask(P0,P1,jb_,qrel,hi,tab);}while(0)
  #define ENDW(tt) do{ if((tt)+3<NT){WAIT_BAR(2);} else if((tt)+2<NT){WAIT_BAR(1);} else {WAIT_BAR(0);} }while(0)
  for(;t+1<NT;t+=2){
    STEP(pB0,pB1,pA0,pA1,t,(t+3<NT),(t+1<NT),(t+1<NT));       ENDW(t);   RESC(); ROT();
    STEP(pA0,pA1,pB0,pB1,t+1,(t+4<NT),(t+2<NT),(t+2<NT));     ENDW(t+1); RESC(); ROT();
  }
  STEP(pB0,pB1,pA0,pA1,NT-1,false,false,false); RESC();
  { float sacc=pB0[0]+pB0[1]; _Pragma("unroll") for(int r=2;r<16;++r)sacc+=pB0[r]; _Pragma("unroll") for(int r=0;r<16;++r)sacc+=pB1[r]; l_reg+=sacc;
    pw0=(u32x4){PKW(pB0,0),PKW(pB0,2),PKW(pB0,4),PKW(pB0,6)};pw1=(u32x4){PKW(pB0,8),PKW(pB0,10),PKW(pB0,12),PKW(pB0,14)};pw2=(u32x4){PKW(pB1,0),PKW(pB1,2),PKW(pB1,4),PKW(pB1,6)};pw3=(u32x4){PKW(pB1,8),PKW(pB1,10),PKW(pB1,12),PKW(pB1,14)};
    SBAR(); pv(o,vb0+sl_cur,PAF(0),PAF(1),PAF(2),PAF(3)); }
  #undef PKW
  #undef PAF
  #undef VFR
  #undef PIN
  #undef MX3
  #undef GAPA
  #undef GAPB
  #undef EX
  #undef VRD
  #undef KRD
  #undef STEP
  #undef ENDW
  {auto rr=__builtin_amdgcn_permlane32_swap(__float_as_uint(l_reg),__float_as_uint(l_reg),false,false);l_reg=__uint_as_float(rr[0])+__uint_as_float(rr[1]);}
  if(hi==0)wsf[32+r32]=l_reg;asm volatile("s_waitcnt lgkmcnt(0)":::"memory");
  float rli[16];
  #pragma unroll
  for(int r=0;r<16;++r)rli[r]=__builtin_amdgcn_rcpf(wsf[32+crow(r,hi)]);
  bf16*Ow=Oh+(long)(q0+wid*QBLK)*PO;
  { bf16*stg=(bf16*)(shm+LDS_OST)+wid*2048;
    #pragma unroll
    for(int r=0;r<16;++r){const int orow=crow(r,hi);
      #pragma unroll
      for(int d0=0;d0<2;++d0)stg[orow*64+d0*32+r32]=__float2bfloat16(o[d0][r]*rli[r]);}
    asm volatile("s_waitcnt lgkmcnt(0)":::"memory");
    #pragma unroll
    for(int i=0;i<4;++i){const int row=i*8+(lane>>3),ch=lane&7; const u32x4 v=*(const u32x4*)(stg+row*64+ch*8); ATTN_STORE16(Ow+(long)row*PO+ch*8,v);} }
  asm volatile("s_waitcnt lgkmcnt(0)\n\ts_barrier":::"memory");
  #undef DMA_K
  #undef DMA_V
  #undef CMASK
  #undef START
  #undef RESC
  #undef ROT
}
constexpr int ATTN_LDS_BYTES=LDS_BYTES;
constexpr int SLOTV=2*SLOTB;
constexpr int LDS2_K=0, LDS2_V=NSLOT*SLOTB, LDS2_WS=LDS2_V+NSLOT*SLOTV, LDS2_OST=LDS2_WS+NW*64*4, LDS2_TAB=LDS2_OST+NW*4096, LDS2_BYTES=LDS2_TAB+512;
template<int THRL> __device__ __forceinline__ void attn_unit2(int qb,const bf16*Qh,const bf16*__restrict__ Kh,const bf16*__restrict__ Vh,bf16*Oh,char*shm){
  int tid_=threadIdx.x; asm volatile("":"+v"(tid_));
  const int tid=tid_,lane=tid&63,r32=lane&31,hi=lane>>5; const int wid=__builtin_amdgcn_readfirstlane(tid>>6);
  const int q0=qb*QB;
  const bf16*Qw=Qh+(long)(q0+wid*QBLK)*PQ;
  const unsigned lds0=(unsigned)(uintptr_t)shm;
  float*wsf=(float*)(shm+LDS2_WS)+wid*64;
  const bf16*ksrc=Kh+(long)lane*PQ+wid*8;
  const bf16*vsrc=Vh+(long)(16*(wid&3)+(lane>>2))*PQ+(wid>>2)*32+(lane&3)*8;
  const unsigned kdst=lds0+LDS2_K+wid*1024, vdst=lds0+LDS2_V+wid*1024;
  #define DMA_K(t,slot) glds16(ksrc+(long)(t)*KVBLK*PQ,(unsigned)__builtin_amdgcn_readfirstlane(kdst+(slot)))
  #define DMA_V(t,slot) do{ glds16(vsrc+(long)(t)*KVBLK*PQ,(unsigned)__builtin_amdgcn_readfirstlane(vdst+2*(slot))); glds16(vsrc+(long)(t)*KVBLK*PQ+64,(unsigned)__builtin_amdgcn_readfirstlane(vdst+2*(slot)+SLOTB)); }while(0)
  const int vb0=(int)(lds0+LDS2_V)+((lane>>4)&1)*32+(lane&3)*8+(4*hi+((lane&15)>>2))*64;
  const char*Kbase=shm+LDS2_K; bf16x8 kf[8];
  const lds_cptr shm3=(lds_cptr)shm; const lds_cptr kp0=shm3+LDS2_K+hi*1024+r32*16; const lds_cptr vp0=shm3+LDS2_V+((lane>>4)&1)*32+(lane&3)*8+(4*hi+((lane&15)>>2))*64;
  const int NT=(q0+QB)/KVBLK;
  DMA_K(0,0);DMA_V(0,0);DMA_K(1,SLOTB);
  bf16x8 qr[4];
  #pragma unroll
  for(int d0=0;d0<4;++d0)qr[d0]=*reinterpret_cast<const bf16x8*>(&Qw[(long)r32*PQ+d0*16+hi*8]);
  float mhat=0.f,l_reg=0.f;f32x16 o[4];o[0]=f32x16{};o[1]=f32x16{};o[2]=f32x16{};o[3]=f32x16{};
  const f32x16 zero16=f32x16{};
  const int qrel=wid*QBLK+r32;
  const lds_cfptr tab=(lds_cfptr)((lds_cptr)shm+LDS2_TAB);
  #define CMASK(P0,P1,t) do{int jb_=(t)-(NT-4); if(jb_>=-2)cmask(P0,P1,jb_,qrel,hi,tab);}while(0)
  bool resc=false;
  #define RESC() do{ if(resc){ asm volatile("s_waitcnt lgkmcnt(0)":::"memory"); \
      _Pragma("unroll") for(int d_=0;d_<4;++d_) _Pragma("unroll") for(int r=0;r<16;++r)o[d_][r]*=wsf[crow(r,hi)]; } }while(0)
  f32x16 c0,c1; u32x4 pa0,pa1,pa2,pa3,pb0,pb1,pb2,pb3;
  int sl_prev=0,sl_cur=0,sl_next=SLOTB;
  #define ROT() do{sl_prev=sl_cur;sl_cur=sl_next;sl_next=(sl_next==(NSLOT-1)*SLOTB)?0:sl_next+SLOTB;}while(0)
  #define PKW(P,B) cvtpk_s(P[B],P[B+1])
  #define EX(v) __builtin_amdgcn_exp2f(v)
  DMA_K(2,2*SLOTB);
  WAIT_BAR(4);
  qkt(c0,c1,Kbase,qr,zero16,r32,hi);asm volatile("s_nop 15\n\ts_nop 7":"+v"(c0),"+v"(c1));CMASK(c0,c1,0);
  { mhat=rowmax(c0,c1);
    _Pragma("unroll") for(int r=0;r<16;++r){c0[r]=EX(c0[r]-mhat);c1[r]=EX(c1[r]-mhat);}
    float sacc=c0[0]+c0[1]; _Pragma("unroll") for(int r=2;r<16;++r)sacc+=c0[r]; _Pragma("unroll") for(int r=0;r<16;++r)sacc+=c1[r]; l_reg=sacc;
    pa0=(u32x4){PKW(c0,0),PKW(c0,2),PKW(c0,4),PKW(c0,6)};pa1=(u32x4){PKW(c0,8),PKW(c0,10),PKW(c0,12),PKW(c0,14)};pa2=(u32x4){PKW(c1,0),PKW(c1,2),PKW(c1,4),PKW(c1,6)};pa3=(u32x4){PKW(c1,8),PKW(c1,10),PKW(c1,12),PKW(c1,14)}; }
  WAIT_BAR(0);
  DMA_K(3,0);DMA_V(1,SLOTB);
  ROT();
  kload8(kf,kp0+sl_cur);
  WAIT_BAR(3);
  s16x4 vlo[8],vhi[8];
  #define PAFX(X,k) __builtin_bit_cast(bf16x8,X##k)
  #define VFR(i) (bf16x8){vlo[i][0],vlo[i][1],vlo[i][2],vlo[i][3],vhi[i][0],vhi[i][1],vhi[i][2],vhi[i][3]}
  #define PIN(x) asm volatile("":"+v"(x))
  #define MX3(a,b,c) __builtin_fmaxf(__builtin_fmaxf((a),(b)),(c))
  #define VRD(i) do{ vlo[i]=vtr(vp_+(((i)>>2)*4096+((i)&3)*1024)); vhi[i]=vtr(vp_+(((i)>>2)*4096+((i)&3)*1024+512)); }while(0)
  #define VRD1(i) do{ vlo[i]=vtr(vp_+(SLOTB+((i)>>2)*4096+((i)&3)*1024)); vhi[i]=vtr(vp_+(SLOTB+((i)>>2)*4096+((i)&3)*1024+512)); }while(0)
  #define KRD(G,j) do{ if(G){ kload2(kf,kp0+sl_next,j); SBAR(); } }while(0)
  #define QKG(MF) do{ MF; SBAR(); }while(0)
  #define GAPB(MF,RD,Xc,B) do{ MF; RD; Xc[B]=EX(Xc[B]-mhat); Xc[B+1]=EX(Xc[B+1]-mhat); Xc[B+2]=EX(Xc[B+2]-mhat); Xc[B+3]=EX(Xc[B+3]-mhat); PIN(Xc); SBAR(); }while(0)
  #define GAPC(MF,A0,A1,A2,A3,W0,W1,PW) do{ MF; sacc+=A0; sacc+=A1; sacc+=A2; sacc+=A3; PIN(sacc); W0; W1; PIN(PW); SBAR(); }while(0)
  #define MF32(a,b,c) __builtin_amdgcn_mfma_f32_32x32x16_bf16(a,b,c,0,0,0)
  #define STEP2(X,Y,t,GK,GV,GL) do{ SBAR(); \
    const lds_cptr vp_=vp0+2*sl_prev; \
    VRD(0); SBAR(); QKG(c0=MF32(kf[0],qr[0],zero16)); \
    VRD(4); SBAR(); QKG(c1=MF32(kf[1],qr[0],zero16)); \
    VRD(1); SBAR(); QKG(c0=MF32(kf[2],qr[1],c0)); \
    VRD(5); SBAR(); QKG(c1=MF32(kf[3],qr[1],c1)); \
    VRD(2); SBAR(); QKG(c0=MF32(kf[4],qr[2],c0)); \
    VRD(6); SBAR(); QKG(c1=MF32(kf[5],qr[2],c1)); \
    VRD(3); SBAR(); QKG(c0=MF32(kf[6],qr[3],c0)); \
    VRD(7); SBAR(); QKG(c1=MF32(kf[7],qr[3],c1)); \
    if(GK){DMA_K((t)+3,sl_cur);} if(GV){DMA_V((t)+1,sl_next);} \
    CMASK(c0,c1,t); \
    { float a=MX3(c0[0],c0[1],c1[0]),b=MX3(c0[2],c0[3],c1[1]); a=MX3(a,c1[2],c1[3]); \
      _Pragma("unroll") for(int r=4;r<16;r+=4){a=MX3(a,c0[r],c0[r+1]);b=MX3(b,c0[r+2],c0[r+3]);a=MX3(a,c1[r],c1[r+1]);b=MX3(b,c1[r+2],c1[r+3]);} \
      float rm=__builtin_fmaxf(a,b); { auto rr=__builtin_amdgcn_permlane32_swap(__float_as_uint(rm),__float_as_uint(rm),false,false); rm=__builtin_fmaxf(__uint_as_float(rr[0]),__uint_as_float(rr[1])); } \
      rm-=mhat; resc=false; \
      if(__builtin_expect(__any(rm>(float)THRL),0)){ const float dl=__builtin_fmaxf(rm,0.f); mhat+=dl; \
        const float f=__builtin_amdgcn_exp2f(-dl); l_reg*=f; if(hi==0)wsf[r32]=f; resc=true; } } \
    SBAR(); \
    GAPB(o[0]=MF32(PAFX(X,0),VFR(0),o[0]), VRD1(0), c0,0); \
    GAPB(o[1]=MF32(PAFX(X,0),VFR(4),o[1]), VRD1(4), c0,4); \
    KRD(GL,0); GAPB(o[0]=MF32(PAFX(X,1),VFR(1),o[0]), VRD1(1), c0,8); \
    KRD(GL,1); GAPB(o[1]=MF32(PAFX(X,1),VFR(5),o[1]), VRD1(5), c0,12); \
    KRD(GL,2); GAPB(o[0]=MF32(PAFX(X,2),VFR(2),o[0]), VRD1(2), c1,0); \
    KRD(GL,3); GAPB(o[1]=MF32(PAFX(X,2),VFR(6),o[1]), VRD1(6), c1,4); \
    GAPB(o[0]=MF32(PAFX(X,3),VFR(3),o[0]), VRD1(3), c1,8); \
    GAPB(o[1]=MF32(PAFX(X,3),VFR(7),o[1]), VRD1(7), c1,12); \
    float sacc=(c0[0]+c0[1]); \
    GAPC(o[2]=MF32(PAFX(X,0),VFR(0),o[2]), c0[2],c0[3],c0[4],c0[5],     Y##0[0]=PKW(c0,0), Y##0[1]=PKW(c0,2), Y##0); \
    GAPC(o[3]=MF32(PAFX(X,0),VFR(4),o[3]), c0[6],c0[7],c0[8],c0[9],     Y##0[2]=PKW(c0,4), Y##0[3]=PKW(c0,6), Y##0); \
    GAPC(o[2]=MF32(PAFX(X,1),VFR(1),o[2]), c0[10],c0[11],c0[12],c0[13], Y##1[0]=PKW(c0,8), Y##1[1]=PKW(c0,10), Y##1); \
    GAPC(o[3]=MF32(PAFX(X,1),VFR(5),o[3]), c0[14],c0[15],c1[0],c1[1],   Y##1[2]=PKW(c0,12),Y##1[3]=PKW(c0,14), Y##1); \
    GAPC(o[2]=MF32(PAFX(X,2),VFR(2),o[2]), c1[2],c1[3],c1[4],c1[5],     Y##2[0]=PKW(c1,0), Y##2[1]=PKW(c1,2), Y##2); \
    GAPC(o[3]=MF32(PAFX(X,2),VFR(6),o[3]), c1[6],c1[7],c1[8],c1[9],     Y##2[2]=PKW(c1,4), Y##2[3]=PKW(c1,6), Y##2); \
    GAPC(o[2]=MF32(PAFX(X,3),VFR(3),o[2]), c1[10],c1[11],c1[12],c1[13], Y##3[0]=PKW(c1,8), Y##3[1]=PKW(c1,10), Y##3); \
    GAPC(o[3]=MF32(PAFX(X,3),VFR(7),o[3]), c1[14],c1[15],0.f,0.f,       Y##3[2]=PKW(c1,12),Y##3[3]=PKW(c1,14), Y##3); \
    l_reg+=sacc; \
    }while(0)
  int t=1;
  #undef CMASK
  #define CMASK(P0,P1,t) do{}while(0)
  for(;t+7<NT;t+=2){
    STEP2(pa,pb,t,true,true,true);     WAIT_BAR(3); RESC(); ROT();
    STEP2(pb,pa,t+1,true,true,true);   WAIT_BAR(3); RESC(); ROT();
  }
  #undef CMASK
  #define CMASK(P0,P1,t) do{int jb_=(t)-(NT-4); if(jb_>=-2)cmask(P0,P1,jb_,qrel,hi,tab);}while(0)
  #define ENDW(tt) do{ if((tt)+3<NT){WAIT_BAR(3);} else if((tt)+2<NT){WAIT_BAR(2);} else {WAIT_BAR(0);} }while(0)
  for(;t+1<NT;t+=2){
    STEP2(pa,pb,t,(t+3<NT),(t+1<NT),(t+1<NT));       ENDW(t);   RESC(); ROT();
    STEP2(pb,pa,t+1,(t+4<NT),(t+2<NT),(t+2<NT));     ENDW(t+1); RESC(); ROT();
  }
  STEP2(pa,pb,NT-1,false,false,false); RESC();
  { SBAR(); pv(o,vb0+2*sl_cur,PAFX(pb,0),PAFX(pb,1),PAFX(pb,2),PAFX(pb,3)); pv(o+2,vb0+2*sl_cur+SLOTB,PAFX(pb,0),PAFX(pb,1),PAFX(pb,2),PAFX(pb,3)); }
  #undef PKW
  #undef PAFX
  #undef VFR
  #undef PIN
  #undef MX3
  #undef GAPB
  #undef GAPC
  #undef QKG
  #undef MF32
  #undef EX
  #undef VRD
  #undef VRD1
  #undef KRD
  #undef STEP2
  #undef ENDW
  {auto rr=__builtin_amdgcn_permlane32_swap(__float_as_uint(l_reg),__float_as_uint(l_reg),false,false);l_reg=__uint_as_float(rr[0])+__uint_as_float(rr[1]);}
  if(hi==0)wsf[32+r32]=l_reg;asm volatile("s_waitcnt lgkmcnt(0)":::"memory");
  float rli[16];
  #pragma unroll
  for(int r=0;r<16;++r)rli[r]=__builtin_amdgcn_rcpf(wsf[32+crow(r,hi)]);
  bf16*Ow=Oh+(long)(q0+wid*QBLK)*PO;
  #pragma unroll
  for(int hv=0;hv<2;++hv){ bf16*stg=(bf16*)(shm+LDS2_OST)+wid*2048;
    #pragma unroll
    for(int r=0;r<16;++r){const int orow=crow(r,hi);
      #pragma unroll
      for(int d0=0;d0<2;++d0)stg[orow*64+d0*32+r32]=__float2bfloat16(o[2*hv+d0][r]*rli[r]);}
    asm volatile("s_waitcnt lgkmcnt(0)":::"memory");
    #pragma unroll
    for(int i=0;i<4;++i){const int row=i*8+(lane>>3),ch=lane&7; const u32x4 v=*(const u32x4*)(stg+row*64+ch*8); ATTN_STORE16(Ow+(long)row*PO+hv*64+ch*8,v);}
    asm volatile("s_waitcnt lgkmcnt(0)":::"memory"); }
  asm volatile("s_waitcnt lgkmcnt(0)\n\ts_barrier":::"memory");
  #undef DMA_K
  #undef DMA_V
  #undef CMASK
  #undef RESC
  #undef ROT
}
#undef SBAR
#undef WAIT_BAR
}

constexpr int NWAVES = 8;
#ifndef MK_PER_PHASE
#define MK_PER_PHASE 0
#endif
constexpr int NPHASE = 20;

constexpr int BATCH = 2, SEQ = 4096, T = BATCH * SEQ, D = 2048;
constexpr int NAB = 6144, NABX = 6160;
constexpr int C_QA = 0, C_KA = 1024, C_VA = 2048, C_QB = 3072, C_KB = 3584, C_VB = 4096, C_RB = 5120;
constexpr int NEXP = 32, FF = 512, CAPROWS = 24576;
constexpr float EPS = 1e-6f;
constexpr float LOG2E = 1.4426950408889634f;

constexpr size_t MiB = 1u << 20;
constexpr size_t WS_CTL = 0, CTL_ZERO_BYTES = 65536;
constexpr size_t WS_WAB = 1 * MiB;
constexpr size_t WS_WOAB = 26 * MiB;
constexpr size_t WS_WINC = 34 * MiB;
constexpr size_t WS_WOC = 50 * MiB;
constexpr size_t WS_WR = 58 * MiB;
constexpr size_t WS_BIAS = 59 * MiB;
constexpr size_t WS_WGU = 60 * MiB;
constexpr size_t WS_WDN = 316 * MiB;
constexpr size_t WS_X = 444 * MiB;
constexpr size_t WS_H = 508 * MiB;
constexpr size_t WS_PROJ = 540 * MiB;
constexpr size_t WS_ORAW = 636 * MiB;
constexpr size_t WS_CAT = 668 * MiB;
constexpr size_t WS_GQ = 700 * MiB, WS_GK = 708 * MiB;
constexpr size_t WS_GB = 716 * MiB;
constexpr size_t WS_STATS = 700 * MiB;
constexpr size_t WS_DEC = 717 * MiB;
constexpr size_t WS_DS = 718 * MiB;
constexpr size_t WS_ST = 782 * MiB;
constexpr size_t WS_ACT = 814 * MiB;
constexpr size_t WS_LIST = 838 * MiB;
constexpr size_t WS_TOK = 839 * MiB;
constexpr size_t WS_END = 840 * MiB;
constexpr int CW_BAR = 4096;
constexpr int CW_MOEUP = 14336, MOEUP_STRIDE = 8;
static_assert((CW_MOEUP + 2 * 96 * MOEUP_STRIDE) * 4 <= 65536 && CW_MOEUP >= 12288 + 1024, "MoE counters inside the memset region");
constexpr int CW_QGEMM = 12288, CW_QCONV = 12288 + 512;
constexpr int NXCD_ = 8;
constexpr int CW_CNT = 8192;
static_assert((CW_QCONV + 8 * 64) * 4 <= (int)CTL_ZERO_BYTES && CW_CNT + 2 * 2048 <= CW_QGEMM, "queue words inside the memset region");
static_assert((CW_CNT + 2 * 2048) * 4 <= (int)CTL_ZERO_BYTES, "CTL words inside the memset region");

constexpr int RING_OFF = 0, RING_BYTES = 131072;
constexpr int SCR_BYTES = 143360;
constexpr int LDSCTL_OFF = SCR_BYTES;
constexpr int MISC_OFF = LDSCTL_OFF;
constexpr int MOE_OFF = LDSCTL_OFF + 256;
constexpr int LDS_BYTES = 147456;

#define GAS __attribute__((address_space(1)))
#define LAS __attribute__((address_space(3)))
typedef unsigned short bf16;
typedef unsigned v4u __attribute__((ext_vector_type(4)));
typedef unsigned v2u __attribute__((ext_vector_type(2)));
typedef float f32x4 __attribute__((ext_vector_type(4)));
typedef short bf16x8 __attribute__((ext_vector_type(8)));
typedef GAS unsigned gu32;
#define RLX_AGENT __ATOMIC_RELAXED, __HIP_MEMORY_SCOPE_AGENT
#define LDS_WAIT() asm volatile("s_waitcnt lgkmcnt(0)" ::: "memory")
#define VM_WAIT() asm volatile("s_waitcnt vmcnt(0)" ::: "memory")
__device__ __forceinline__ unsigned f2bf(float f) { unsigned u = __builtin_bit_cast(unsigned, f); return (u + 0x7fffu + ((u >> 16) & 1u)) >> 16; }
__device__ __forceinline__ unsigned pk2(float lo, float hi) { return f2bf(lo) | (f2bf(hi) << 16); }
__device__ __forceinline__ float bf2f(unsigned short b) { return __builtin_bit_cast(float, (unsigned)b << 16); }
__device__ __forceinline__ float bflo(unsigned w) { return __builtin_bit_cast(float, w << 16); }
__device__ __forceinline__ float bfhi(unsigned w) { return __builtin_bit_cast(float, w & 0xffff0000u); }

#define XB_TMO      128
#define XB_XCNT(j)  (256  + 64 * (j))
#define XB_XSUB(j)  (1280 + 64 * (j))
#define XB_XGEN(j)  (2304 + 64 * (j))
#define XB_TOP      3328
#define XB_TOPGEN   3392
#define XCD_BAR_WORDS 3456
#define XB_SPIN_CAP (1u << 18)

__device__ __forceinline__ unsigned xb_ld(unsigned* p)              { return __hip_atomic_load(p, __ATOMIC_RELAXED, __HIP_MEMORY_SCOPE_AGENT); }
__device__ __forceinline__ unsigned xb_add(unsigned* p, unsigned v) { return __hip_atomic_fetch_add(p, v, __ATOMIC_RELAXED, __HIP_MEMORY_SCOPE_AGENT); }
__device__ __forceinline__ unsigned xb_xcc_id() { return (unsigned)__builtin_amdgcn_s_getreg((3 << 11) | 20) & 0xFu; }
#define XB_SPIN(cond, bar) do { unsigned _sp = 0; while (cond) { __builtin_amdgcn_s_sleep(1); \
    if ((++_sp & 255u) == 0u) { if (xb_ld(&(bar)[XB_TMO])) break; if (_sp > XB_SPIN_CAP) { atomicAdd(&(bar)[XB_TMO], 1u); break; } } } } while (0)

struct XcdBarrier {
    unsigned* bar; unsigned x;
    volatile LAS unsigned* st;
};
__device__ __forceinline__ XcdBarrier xcd_barrier_post(unsigned* bar, volatile LAS unsigned* st) {
    XcdBarrier b; b.bar = bar; b.x = xb_xcc_id(); b.st = st;
    if (threadIdx.x == 0) (void)xb_add(&bar[XB_XCNT(b.x)], 1u);
    return b;
}
__device__ __forceinline__ void xcd_barrier_complete(unsigned* bar, unsigned x, unsigned& nloc, unsigned& nx) {
    const unsigned G = gridDim.x * gridDim.y * gridDim.z;
    unsigned sum, cnt, mine, sp = 0u;
    for (;;) {
        sum = 0u; cnt = 0u; mine = 0u;
#pragma unroll
        for (unsigned j = 0; j < 16; ++j) { const unsigned c = xb_ld(&bar[XB_XCNT(j)]); sum += c; cnt += (c > 0u) ? 1u : 0u; mine = (j == x) ? c : mine; }
        if (sum == G) break;
        __builtin_amdgcn_s_sleep(1);
        if ((++sp & 255u) == 0u) { if (xb_ld(&bar[XB_TMO])) break; if (sp > XB_SPIN_CAP) { atomicAdd(&bar[XB_TMO], 1u); break; } }
    }
    nloc = mine > 0u ? mine : 1u; nx = cnt > 0u ? cnt : 1u;
}
__device__ __forceinline__ void xcd_barrier(const XcdBarrier& b) {
    asm volatile("s_waitcnt vmcnt(0)" ::: "memory");
    __syncthreads();
    if (threadIdx.x == 0) {
        unsigned* bar = b.bar;
        __builtin_amdgcn_s_waitcnt(0);
        unsigned nloc = b.st[0], nx = b.st[1];
        if (nloc == 0u) { xcd_barrier_complete(bar, b.x, nloc, nx); b.st[0] = nloc; b.st[1] = nx; }
        const unsigned old = xb_add(&bar[XB_XSUB(b.x)], 1u);
        const unsigned gen = old / nloc;
        if (old + 1u == (gen + 1u) * nloc) {
            __builtin_amdgcn_fence(__ATOMIC_RELEASE, "agent");
            asm volatile("s_waitcnt vmcnt(0)" ::: "memory");
            const unsigned og = xb_add(&bar[XB_TOP], 1u);
            const unsigned tg = og / nx;
            if (og + 1u == (tg + 1u) * nx) xb_add(&bar[XB_TOPGEN], 1u);
            else XB_SPIN(xb_ld(&bar[XB_TOPGEN]) == tg, bar);
            __builtin_amdgcn_fence(__ATOMIC_ACQUIRE, "agent");
            xb_add(&bar[XB_XGEN(b.x)], 1u);
            asm volatile("s_waitcnt vmcnt(0)" ::: "memory");
        } else {
            XB_SPIN(xb_ld(&bar[XB_XGEN(b.x)]) == gen, bar);
            __builtin_amdgcn_fence(__ATOMIC_ACQUIRE, "agent");
            asm volatile("s_waitcnt vmcnt(0)" ::: "memory");
        }
    }
    __syncthreads();
}

struct Frame {
    LAS unsigned char* lds;
    gu32* ctl;
    unsigned char* ws;
    int tid, lane, wave;
    int vcu, G;
};
__device__ __forceinline__ float wave_sum(float v) {
#pragma unroll
    for (int o = 1; o < 64; o <<= 1) v += __shfl_xor(v, o);
    return v;
}
#define WG_SYNC() do { asm volatile("s_waitcnt vmcnt(0) lgkmcnt(0)" ::: "memory"); __builtin_amdgcn_s_barrier(); asm volatile("" ::: "memory"); } while (0)

struct XItem { const float* W; bf16* dst; int ldw, ldd, k0, n0; };
__device__ __forceinline__ unsigned cvtpk_hw(float lo, float hi) { typedef float f2_t __attribute__((ext_vector_type(2))); typedef __bf16 b2_t __attribute__((ext_vector_type(2))); f2_t v = {lo, hi}; b2_t r = __builtin_convertvector(v, b2_t); return __builtin_bit_cast(unsigned, r); }
__device__ __forceinline__ void xpose_load(const XItem& x, f32x4 (&xs)[8], int lane) {
    const char* base = (const char*)(x.W + (size_t)x.k0 * x.ldw + x.n0);
    const unsigned loff = ((unsigned)(lane >> 3) * 8u * (unsigned)x.ldw + 4u * (unsigned)(lane & 7)) * 4u;
    const size_t rstep = (size_t)x.ldw * 4;
#pragma unroll
    for (int i = 0; i < 8; ++i) xs[i] = __builtin_nontemporal_load((const f32x4*)(base + i * rstep + loff));
}
__device__ __forceinline__ void xpose_finish(const XItem& x, const f32x4 (&xs)[8], LAS float*, int lane) {
    const int src4 = 4 * ((lane >> 3) + 8 * (lane & 7));
    char* dbase = (char*)(x.dst + x.k0);
    const unsigned doff = ((unsigned)(4 * (lane >> 3)) * (unsigned)x.ldd + 8u * (unsigned)(lane & 7)) * 2u;
    const size_t dstep = (size_t)x.ldd * 2;
#define XP_ONE(E, M) { v4u o; o.x = (unsigned)__builtin_amdgcn_ds_bpermute(src4, (int)cvtpk_hw(xs[0].M, xs[1].M)); o.y = (unsigned)__builtin_amdgcn_ds_bpermute(src4, (int)cvtpk_hw(xs[2].M, xs[3].M)); \
        o.z = (unsigned)__builtin_amdgcn_ds_bpermute(src4, (int)cvtpk_hw(xs[4].M, xs[5].M)); o.w = (unsigned)__builtin_amdgcn_ds_bpermute(src4, (int)cvtpk_hw(xs[6].M, xs[7].M)); \
        __builtin_nontemporal_store(o, (v4u*)(dbase + (E) * dstep + doff)); }
    XP_ONE(0, x) XP_ONE(1, y) XP_ONE(2, z) XP_ONE(3, w)
#undef XP_ONE
}
__device__ const unsigned char T5_BUCKET[128] = {
    0, 1, 2, 3, 4, 5, 6, 7, 8, 9, 10, 11, 12, 13, 14, 15, 16, 16, 16, 17, 17, 18, 18, 18, 19, 19, 19, 20, 20, 20, 20, 21, 21, 21, 21, 22, 22, 22, 22, 22, 23, 23, 23, 23, 23, 23, 24, 24, 24, 24, 24, 24,
    25, 25, 25, 25, 25, 25, 25, 26, 26, 26, 26, 26, 26, 26, 26, 27, 27, 27, 27, 27, 27, 27, 27, 27, 27, 28, 28, 28, 28, 28, 28, 28, 28, 28, 28, 29, 29, 29, 29, 29, 29, 29, 29, 29, 29, 29, 29,
    30, 30, 30, 30, 30, 30, 30, 30, 30, 30, 30, 30, 30, 30, 31, 31, 31, 31, 31, 31, 31, 31, 31, 31, 31, 31, 31, 31, 31};

struct P0Args { const float *w_in_ab, *w_out_ab, *w_in_c, *w_out_c, *w_gate, *w_up, *w_down, *rel_bias; };
constexpr int P0_I_AB = 32 * 192, P0_I_SQ = 32 * 64, P0_I_C = 32 * 128, P0_I_E = 512 * 64;
constexpr int P0_NITEMS = P0_I_AB + P0_I_SQ + P0_I_C + P0_I_SQ + 3 * P0_I_E;
constexpr int P0_TICK = 8;
constexpr int P0_NTICK_XCD = (P0_NITEMS - P0_I_AB) / P0_TICK / NXCD_;
static_assert((P0_NITEMS - P0_I_AB) % (P0_TICK * NXCD_) == 0, "ticket split");
__device__ __forceinline__ XItem p0_decode(const P0Args& a, unsigned char* ws, int it) {
    constexpr int I_AB = P0_I_AB, I_SQ = P0_I_SQ, I_C = P0_I_C, I_E = P0_I_E;
    bf16* WAB = (bf16*)(ws + WS_WAB); bf16* WOAB = (bf16*)(ws + WS_WOAB); bf16* WINC = (bf16*)(ws + WS_WINC); bf16* WOC = (bf16*)(ws + WS_WOC);
    bf16* WGU = (bf16*)(ws + WS_WGU); bf16* WDN = (bf16*)(ws + WS_WDN);
    int r = it;
    if (r < I_AB) { const int kb = r / 192, nb = r % 192; return XItem{a.w_in_ab, WAB + (size_t)(32 * nb) * D, NABX, D, 64 * kb, 32 * nb}; } r -= I_AB;
    if (r < I_SQ) { const int kb = r / 64, nb = r % 64; return XItem{a.w_out_ab, WOAB + (size_t)(32 * nb) * D, D, D, 64 * kb, 32 * nb}; } r -= I_SQ;
    if (r < I_C) { const int kb = r / 128, nb = r % 128; return XItem{a.w_in_c, WINC + (size_t)(32 * nb) * D, 2 * D, D, 64 * kb, 32 * nb}; } r -= I_C;
    if (r < I_SQ) { const int kb = r / 64, nb = r % 64; return XItem{a.w_out_c, WOC + (size_t)(32 * nb) * D, D, D, 64 * kb, 32 * nb}; } r -= I_SQ;
    if (r < 2 * I_E) {
        const int up = r >= I_E; if (up) r -= I_E;
        const int le = r >> 9, q = r & 511, kb = q >> 4, nb = q & 15, n0 = 32 * nb, row = 256 * (n0 >> 7) + (n0 & 127) + 128 * up;
        return XItem{(up ? a.w_up : a.w_gate) + (size_t)le * D * FF, WGU + ((size_t)le * 1024 + row) * D, FF, D, 64 * kb, n0}; }
    r -= 2 * I_E;
    const int le = r >> 9, q = r & 511, kb = q >> 6, nb = q & 63;
    return XItem{a.w_down + (size_t)le * FF * D, WDN + ((size_t)le * D + 32 * nb) * FF, D, FF, 64 * kb, 32 * nb};
}
__device__ __forceinline__ void p0_convert(Frame& F, const P0Args& a, int nitems) {
    LAS float* scr = (LAS float*)(F.lds + RING_OFF + F.wave * 16384);
    const int gw = F.vcu * NWAVES + F.wave, NGW = F.G * NWAVES;
    if (gw < nitems) {
        XItem cur = p0_decode(a, F.ws, gw); f32x4 xa[8], xb[8]; xpose_load(cur, xa, F.lane);
        int it = gw;
        for (; it + NGW < nitems; it += NGW) {
            const XItem nxt = p0_decode(a, F.ws, it + NGW); xpose_load(nxt, xb, F.lane);
            xpose_finish(cur, xa, scr, F.lane);
            cur = nxt;
#pragma unroll
            for (int i = 0; i < 8; ++i) xa[i] = xb[i];
        }
        xpose_finish(cur, xa, scr, F.lane);
    }
    if (gw == 0) {
        float* bt = (float*)(F.ws + WS_BIAS);
        for (int i = F.lane; i < 8 * 128; i += 64) { const int h = i >> 7, r = i & 127; bt[i] = (a.rel_bias[(int)T5_BUCKET[r] * 8 + h] - a.rel_bias[31 * 8 + h]) * LOG2E; }
    }
}
__device__ __forceinline__ void p0_convert_stream(Frame& F, const P0Args& a, int xcd) {
    LAS float* scr = nullptr;
    unsigned* ctr = (unsigned*)(F.ctl + CW_QCONV + xcd * 64);
    const int base = P0_I_AB + xcd * P0_NTICK_XCD * P0_TICK;
    int tnraw = 0; if (F.lane == 0) tnraw = (int)__hip_atomic_fetch_add(ctr, 1u, __ATOMIC_RELAXED, __HIP_MEMORY_SCOPE_AGENT);
    int it = 0, left = 0; bool done = false;
    auto gen = [&]() -> int {
        if (done) return -1;
        if (left == 0) { const int tn = __builtin_amdgcn_readfirstlane(tnraw); if (tn >= P0_NTICK_XCD) { done = true; return -1; }
            it = base + tn * P0_TICK; left = P0_TICK; if (F.lane == 0) tnraw = (int)__hip_atomic_fetch_add(ctr, 1u, __ATOMIC_RELAXED, __HIP_MEMORY_SCOPE_AGENT); }
        --left; return it++; };
    f32x4 x0[8], x1[8], x2[8], x3[8];
#define P0_FIN(I, X) xpose_finish(p0_decode(a, F.ws, (I)), X, scr, F.lane)
    int i0 = gen(); if (i0 < 0) return;
    xpose_load(p0_decode(a, F.ws, i0), x0, F.lane);
    int i1 = gen(); if (i1 < 0) { P0_FIN(i0, x0); return; }
    xpose_load(p0_decode(a, F.ws, i1), x1, F.lane);
    int i2 = gen(); if (i2 < 0) { P0_FIN(i0, x0); P0_FIN(i1, x1); return; }
    xpose_load(p0_decode(a, F.ws, i2), x2, F.lane);
#define P0_STEP(XL, XF, XA, XB) { const int in_ = gen(); if (in_ < 0) { P0_FIN(i0, XF); P0_FIN(i1, XA); P0_FIN(i2, XB); return; } \
        xpose_load(p0_decode(a, F.ws, in_), XL, F.lane); P0_FIN(i0, XF); i0 = i1; i1 = i2; i2 = in_; }
    for (;;) { P0_STEP(x3, x0, x1, x2) P0_STEP(x0, x1, x2, x3) P0_STEP(x1, x2, x3, x0) P0_STEP(x2, x3, x0, x1) }
#undef P0_STEP
#undef P0_FIN
}

constexpr int AS_PITCH = 2052;
constexpr int PS_OFF = 131584;
constexpr int AH_PITCH = 2056, AL_OFF = 16 * AH_PITCH * 2;
template <bool COMBINE, int OUTMODE, int SKINNY>
__device__ __forceinline__ void norm16_rows(Frame& F, int task, const float* xin, float* xout, const float* gain, bf16* H, float* OUT,
                                            const int* tokinfo, const float* gates, const bf16* ybuf, const LAS int* tstart) {
    LAS float* A_s = (LAS float*)(F.lds);
#pragma unroll
    for (int rr = 0; rr < 2; ++rr) {
        const int rl = 2 * F.wave + rr, row = 16 * task + rl;
        const GAS f32x4* xr = (const GAS f32x4*)(xin + (size_t)row * D) + F.lane;
        f32x4 v[8];
#pragma unroll
        for (int j = 0; j < 8; ++j) v[j] = xr[64 * j];
        if (COMBINE) {
            const int e0 = tokinfo[4 * row], s0 = tokinfo[4 * row + 1], e1 = tokinfo[4 * row + 2], s1 = tokinfo[4 * row + 3];
            const float g0 = gates[2 * row], g1 = gates[2 * row + 1];
            const size_t r0 = (size_t)(tstart[e0] * 256 + s0), r1 = (size_t)(tstart[e1] * 256 + s1);
            const GAS v2u* y0 = (const GAS v2u*)(ybuf + r0 * D) + F.lane; const GAS v2u* y1 = (const GAS v2u*)(ybuf + r1 * D) + F.lane;
#pragma unroll
            for (int j = 0; j < 8; ++j) { const v2u a = y0[64 * j], b = y1[64 * j];
                v[j].x += g0 * bflo(a.x) + g1 * bflo(b.x); v[j].y += g0 * bfhi(a.x) + g1 * bfhi(b.x); v[j].z += g0 * bflo(a.y) + g1 * bflo(b.y); v[j].w += g0 * bfhi(a.y) + g1 * bfhi(b.y); }
            if (OUTMODE == 0) { GAS f32x4* xo = (GAS f32x4*)(xout + (size_t)row * D) + F.lane;
#pragma unroll
                for (int j = 0; j < 8; ++j) xo[64 * j] = v[j]; }
        }
        float s = 0.f;
#pragma unroll
        for (int j = 0; j < 8; ++j) s += (v[j].x * v[j].x + v[j].y * v[j].y) + (v[j].z * v[j].z + v[j].w * v[j].w);
        const float rstd = 1.0f / sqrtf(wave_sum(s) * (1.f / D) + EPS);
        const GAS f32x4* gr = (const GAS f32x4*)gain + F.lane;
#pragma unroll
        for (int j = 0; j < 8; ++j) { const f32x4 g = gr[64 * j]; v[j] = v[j] * rstd * g; }
        if (OUTMODE == 0) { GAS v2u* o8 = (GAS v2u*)(H + (size_t)row * D) + F.lane;
#pragma unroll
            for (int j = 0; j < 8; ++j) { v2u o; o.x = pk2(v[j].x, v[j].y); o.y = pk2(v[j].z, v[j].w); o8[64 * j] = o; } }
        else { GAS f32x4* oo = (GAS f32x4*)(OUT + (size_t)row * D) + F.lane;
#pragma unroll
            for (int j = 0; j < 8; ++j) oo[64 * j] = v[j]; }
        if (SKINNY == 1) {
#pragma unroll
            for (int j = 0; j < 8; ++j) *(LAS f32x4*)(A_s + rl * AS_PITCH + 4 * (F.lane + 64 * j)) = v[j];
        }
        if (SKINNY == 2) {
            LAS bf16* AH = (LAS bf16*)(F.lds); LAS bf16* AL = (LAS bf16*)(F.lds + AL_OFF);
#pragma unroll
            for (int j = 0; j < 8; ++j) { const unsigned h0 = f2bf(v[j].x), h1 = f2bf(v[j].y), h2 = f2bf(v[j].z), h3 = f2bf(v[j].w);
                const float l0 = v[j].x - __builtin_bit_cast(float, h0 << 16), l1 = v[j].y - __builtin_bit_cast(float, h1 << 16), l2 = v[j].z - __builtin_bit_cast(float, h2 << 16), l3 = v[j].w - __builtin_bit_cast(float, h3 << 16);
                *(LAS v2u*)(AH + rl * AH_PITCH + 4 * (F.lane + 64 * j)) = (v2u){h0 | (h1 << 16), h2 | (h3 << 16)};
                *(LAS v2u*)(AL + rl * AH_PITCH + 4 * (F.lane + 64 * j)) = (v2u){pk2(l0, l1), pk2(l2, l3)}; }
        }
    }
}
template <int NT, class BSrc>
__device__ __forceinline__ void skinny16(Frame& F, const BSrc& bsrc) {
#if defined(DBG_NAIVE_SKINNY)
    {   const LAS float* A_s = (const LAS float*)(F.lds); const int row = F.tid >> 5, c32 = F.tid & 31; float r0 = 0.f, r1 = 0.f;
        for (int k = 0; k < D; ++k) { const float a = A_s[row * AS_PITCH + k]; r0 += a * bsrc(k, c32); if (c32 + 32 < 16 * NT) r1 += a * bsrc(k, c32 + 32); }
        WG_SYNC();
        LAS float* PS = (LAS float*)(F.lds + PS_OFF);
        if (c32 < 16 * NT) PS[row * 48 + c32] = r0; if (c32 + 32 < 16 * NT) PS[row * 48 + c32 + 32] = r1;
        WG_SYNC(); return; }
#endif
    const LAS float* A_s = (const LAS float*)(F.lds);
    const int i = F.lane & 15, kq = F.lane >> 4;
    f32x4 acc[NT];
#pragma unroll
    for (int t = 0; t < NT; ++t) acc[t] = (f32x4){0.f, 0.f, 0.f, 0.f};
    const int kbase = 256 * F.wave;
#pragma unroll 8
    for (int s = 0; s < 64; ++s) {
        const int k = kbase + 4 * s + kq; const float a = A_s[i * AS_PITCH + k];
#pragma unroll
        for (int t = 0; t < NT; ++t) { const float b = bsrc(k, 16 * t + i); acc[t] = __builtin_amdgcn_mfma_f32_16x16x4f32(a, b, acc[t], 0, 0, 0); }
    }
    WG_SYNC();
    LAS float* PP = (LAS float*)(F.lds);
#pragma unroll
    for (int t = 0; t < NT; ++t)
#pragma unroll
        for (int j = 0; j < 4; ++j) PP[((F.wave * NT + t) * 16 + 4 * kq + j) * 16 + i] = acc[t][j];
    WG_SYNC();
    LAS float* PS = (LAS float*)(F.lds + PS_OFF);
    for (int idx = F.tid; idx < NT * 256; idx += NWAVES * 64) { const int t = idx >> 8, rc = idx & 255; float s = 0.f;
#pragma unroll
        for (int w = 0; w < 8; ++w) s += PP[((w * NT + t) * 256) + rc];
        PS[(rc >> 4) * 48 + 16 * t + (rc & 15)] = s; }
    WG_SYNC();
}
__device__ __forceinline__ void skinny16_bf3(Frame& F, const bf16* WH, const bf16* WL) {
    const LAS bf16* AH = (const LAS bf16*)(F.lds); const LAS bf16* AL = (const LAS bf16*)(F.lds + AL_OFF);
    const int i = F.lane & 15, kq = F.lane >> 4;
    f32x4 acc[3];
#pragma unroll
    for (int t = 0; t < 3; ++t) acc[t] = (f32x4){0.f, 0.f, 0.f, 0.f};
#pragma unroll 4
    for (int s = 0; s < 8; ++s) { const int k0 = 32 * (8 * F.wave + s) + 8 * kq;
        const bf16x8 ah = *(const LAS bf16x8*)(AH + i * AH_PITCH + k0), al = *(const LAS bf16x8*)(AL + i * AH_PITCH + k0);
#pragma unroll
        for (int t = 0; t < 3; ++t) { const bf16x8 bh = *(const GAS bf16x8*)(WH + (size_t)(16 * t + i) * D + k0), bl = *(const GAS bf16x8*)(WL + (size_t)(16 * t + i) * D + k0);
            acc[t] = __builtin_amdgcn_mfma_f32_16x16x32_bf16(ah, bh, acc[t], 0, 0, 0);
            acc[t] = __builtin_amdgcn_mfma_f32_16x16x32_bf16(ah, bl, acc[t], 0, 0, 0);
            acc[t] = __builtin_amdgcn_mfma_f32_16x16x32_bf16(al, bh, acc[t], 0, 0, 0); } }
    WG_SYNC();
    LAS float* PP = (LAS float*)(F.lds);
#pragma unroll
    for (int t = 0; t < 3; ++t)
#pragma unroll
        for (int j = 0; j < 4; ++j) PP[((F.wave * 3 + t) * 16 + 4 * kq + j) * 16 + i] = acc[t][j];
    WG_SYNC();
    LAS float* PS = (LAS float*)(F.lds + PS_OFF);
    for (int idx = F.tid; idx < 3 * 256; idx += NWAVES * 64) { const int t = idx >> 8, rc = idx & 255; float s = 0.f;
#pragma unroll
        for (int w = 0; w < 8; ++w) s += PP[((w * 3 + t) * 256) + rc];
        PS[(rc >> 4) * 48 + 16 * t + (rc & 15)] = s; }
    WG_SYNC();
}
__device__ __forceinline__ void p0_router_weights(Frame& F, const float* w_rg, const float* w_re, const float* nffn) {
    bf16* WR = (bf16*)(F.ws + WS_WR);
    for (int idx = (int)blockIdx.x * (NWAVES * 64) + F.tid; idx < 2 * 48 * D; idx += F.G * NWAVES * 64) {
        const int l = idx / (48 * D), r = idx % (48 * D), k = r / 48, c = r % 48;
        const float v = (c < 4 ? w_rg[((size_t)l * D + k) * 4 + c] : (c < 36 ? w_re[((size_t)l * D + k) * 32 + c - 4] : 0.f)) * nffn[(size_t)l * D + k];
        const unsigned h = f2bf(v); const float lo = v - __builtin_bit_cast(float, h << 16);
        WR[((size_t)(l * 2 + 0) * 48 + c) * D + k] = (bf16)h; WR[((size_t)(l * 2 + 1) * 48 + c) * D + k] = (bf16)f2bf(lo); }
}
struct GbSrc { const float* w; __device__ __forceinline__ float operator()(int k, int col) const { return w[(size_t)k * NABX + NAB + col]; } };
struct RouterSrc { const float* wg; const float* we;
    __device__ __forceinline__ float operator()(int k, int col) const { return col < 4 ? wg[k * 4 + col] : (col < 36 ? we[k * 32 + col - 4] : 0.f); } };

__device__ __forceinline__ void route16(Frame& F, int task, int layer) {
    const LAS float* PS = (const LAS float*)(F.lds + PS_OFF);
    LAS int* agg = (LAS int*)(F.lds + PS_OFF + 16 * 48 * 4);
    if (F.tid < 64) {
        if (F.tid < 32) agg[F.tid] = 0;
        LDS_WAIT();
        int row = 0, e0 = 0, e1 = 0, r0 = 0, r1 = 0; float g0 = 0.f, g1 = 0.f;
        if (F.tid < 16) {
            row = 16 * task + F.tid; const LAS float* lg = PS + F.tid * 48;
            int g = 0; float mg = lg[0];
#pragma unroll
            for (int j = 1; j < 4; ++j) { const float x = lg[j]; if (x > mg) { mg = x; g = j; } }
            float sg = 0.f;
#pragma unroll
            for (int j = 0; j < 4; ++j) sg += expf(lg[j] - mg);
            const float pg = 1.0f / sg;
            const LAS float* le = lg + 4 + 8 * g;
            int i0 = 0; float m0 = le[0];
#pragma unroll
            for (int j = 1; j < 8; ++j) { const float x = le[j]; if (x > m0) { m0 = x; i0 = j; } }
            int i1 = -1; float m1 = -INFINITY;
#pragma unroll
            for (int j = 0; j < 8; ++j) { const float x = le[j]; if (j != i0 && x > m1) { m1 = x; i1 = j; } }
            const float p1 = expf(m1 - m0), inv = 1.0f / (1.0f + p1);
            e0 = 8 * g + i0; e1 = 8 * g + i1; g0 = pg * inv; g1 = pg * p1 * inv;
            r0 = __hip_atomic_fetch_add(agg + e0, 1, __ATOMIC_RELAXED, __HIP_MEMORY_SCOPE_WORKGROUP);
            r1 = __hip_atomic_fetch_add(agg + e1, 1, __ATOMIC_RELAXED, __HIP_MEMORY_SCOPE_WORKGROUP);
        }
        LDS_WAIT();
        if (F.tid < 32) { const int c = agg[F.tid]; if (c > 0) agg[32 + F.tid] = (int)atomicAdd((unsigned*)(F.ctl + CW_CNT + layer * 2048) + F.tid * 64, (unsigned)c); }
        LDS_WAIT();
        if (F.tid < 16) {
            const int s0 = agg[32 + e0] + r0, s1 = agg[32 + e1] + r1;
            int* list = (int*)(F.ws + WS_LIST); int* tok = (int*)(F.ws + WS_TOK); float* gates = (float*)(F.ws + WS_TOK + 262144);
            list[e0 * 8192 + s0] = row; list[e1 * 8192 + s1] = row;
            tok[4 * row] = e0; tok[4 * row + 1] = s0; tok[4 * row + 2] = e1; tok[4 * row + 3] = s1;
            gates[2 * row] = g0; gates[2 * row + 1] = g1;
        }
    }
}
__device__ __forceinline__ void router_pair(Frame& F, int layer, const float* X, const bf16* DL, const float* gain, bf16* H, const bf16* WH, const bf16* WL) {
    const int lane = F.lane, i = lane & 15, g = lane >> 4, w = F.wave;
    const int t0 = F.vcu, t1 = F.vcu + F.G;
    const int kb = 256 * w + 8 * g;
    const GAS f32x4* xr0 = (const GAS f32x4*)(X + (size_t)(16 * t0 + i) * D + kb); const GAS f32x4* xr1 = (const GAS f32x4*)(X + (size_t)(16 * t1 + i) * D + kb);
    f32x4 xa[2][8][2];
#pragma unroll
    for (int s = 0; s < 8; ++s) { xa[0][s][0] = xr0[8 * s]; xa[0][s][1] = xr0[8 * s + 1]; xa[1][s][0] = xr1[8 * s]; xa[1][s][1] = xr1[8 * s + 1]; }
    if (DL != nullptr) {   const GAS v4u* d0 = (const GAS v4u*)(DL + (size_t)(16 * t0 + i) * D + kb); const GAS v4u* d1 = (const GAS v4u*)(DL + (size_t)(16 * t1 + i) * D + kb);
        v4u da[2][8];
#pragma unroll
        for (int s = 0; s < 8; ++s) { da[0][s] = d0[4 * s]; da[1][s] = d1[4 * s]; }
#pragma unroll
        for (int rg = 0; rg < 2; ++rg)
#pragma unroll
            for (int s = 0; s < 8; ++s) { const v4u q = da[rg][s]; f32x4& a = xa[rg][s][0]; f32x4& b = xa[rg][s][1];
                a.x += bflo(q.x); a.y += bfhi(q.x); a.z += bflo(q.y); a.w += bfhi(q.y); b.x += bflo(q.z); b.y += bfhi(q.z); b.z += bflo(q.w); b.w += bfhi(q.w); } }
#pragma unroll
    for (int s = 0; s < 8; ++s) asm volatile("" : "+v"(xa[0][s][0]), "+v"(xa[0][s][1]), "+v"(xa[1][s][0]), "+v"(xa[1][s][1]));
    f32x4 acc[2][3]; float ss[2] = {0.f, 0.f};
#pragma unroll
    for (int rg = 0; rg < 2; ++rg)
#pragma unroll
        for (int t = 0; t < 3; ++t) acc[rg][t] = (f32x4){0.f, 0.f, 0.f, 0.f};
#pragma unroll
    for (int s = 0; s < 8; ++s) { const int k0 = kb + 32 * s;
        if ((s & 1) == 0) asm volatile("" ::: "memory");
        bf16x8 bh[3], bl[3];
#pragma unroll
        for (int t = 0; t < 3; ++t) { bh[t] = *(const GAS bf16x8*)(WH + (size_t)(16 * t + i) * D + k0); bl[t] = *(const GAS bf16x8*)(WL + (size_t)(16 * t + i) * D + k0); }
#pragma unroll
        for (int rg = 0; rg < 2; ++rg) { const f32x4 a = xa[rg][s][0], b = xa[rg][s][1];
            ss[rg] += (a.x * a.x + a.y * a.y) + (a.z * a.z + a.w * a.w) + (b.x * b.x + b.y * b.y) + (b.z * b.z + b.w * b.w);
            v4u hi, lo; hi.x = cvtpk_hw(a.x, a.y); hi.y = cvtpk_hw(a.z, a.w); hi.z = cvtpk_hw(b.x, b.y); hi.w = cvtpk_hw(b.z, b.w);
            lo.x = cvtpk_hw(a.x - bflo(hi.x), a.y - bfhi(hi.x)); lo.y = cvtpk_hw(a.z - bflo(hi.y), a.w - bfhi(hi.y)); lo.z = cvtpk_hw(b.x - bflo(hi.z), b.y - bfhi(hi.z)); lo.w = cvtpk_hw(b.z - bflo(hi.w), b.w - bfhi(hi.w));
            const bf16x8 ah = __builtin_bit_cast(bf16x8, hi), al = __builtin_bit_cast(bf16x8, lo);
#pragma unroll
            for (int t = 0; t < 3; ++t) { acc[rg][t] = __builtin_amdgcn_mfma_f32_16x16x32_bf16(ah, bh[t], acc[rg][t], 0, 0, 0);
                acc[rg][t] = __builtin_amdgcn_mfma_f32_16x16x32_bf16(ah, bl[t], acc[rg][t], 0, 0, 0);
                acc[rg][t] = __builtin_amdgcn_mfma_f32_16x16x32_bf16(al, bh[t], acc[rg][t], 0, 0, 0); } } }
    LAS float* PP = (LAS float*)(F.lds);
    LAS float* SS = (LAS float*)(F.lds + 49152);
    LAS float* PS = (LAS float*)(F.lds + PS_OFF);
    LAS float* RSTD = (LAS float*)(F.lds + PS_OFF + 32 * 48 * 4);
    LAS int* agg = (LAS int*)(F.lds + PS_OFF + 32 * 48 * 4 + 128);
#pragma unroll
    for (int rg = 0; rg < 2; ++rg) { float q = ss[rg]; q += __shfl_xor(q, 16); q += __shfl_xor(q, 32); if (g == 0) SS[w * 32 + 16 * rg + i] = q;
#pragma unroll
        for (int t = 0; t < 3; ++t)
#pragma unroll
            for (int j = 0; j < 4; ++j) PP[(((w * 2 + rg) * 3 + t) * 16 + 4 * g + j) * 16 + i] = acc[rg][t][j]; }
    WG_SYNC();
    for (int idx = F.tid; idx < 2 * 768; idx += NWAVES * 64) { const int rg = idx >= 768, r2 = idx - 768 * rg, t = r2 >> 8, rc = r2 & 255; float q = 0.f;
#pragma unroll
        for (int ww = 0; ww < 8; ++ww) q += PP[((ww * 2 + rg) * 3 + t) * 256 + rc];
        PS[(16 * rg + (rc >> 4)) * 48 + 16 * t + (rc & 15)] = q; }
    if (F.tid < 32) { float q = 0.f;
#pragma unroll
        for (int ww = 0; ww < 8; ++ww) q += SS[ww * 32 + F.tid];
        RSTD[F.tid] = 1.0f / sqrtf(q * (1.f / D) + EPS); agg[F.tid] = 0; }
    WG_SYNC();
    {   const float r0 = RSTD[i], r1 = RSTD[16 + i];
        int i2 = lane & 15, kb2 = 256 * w + 8 * (lane >> 4); asm volatile("" : "+v"(i2), "+v"(kb2));
        bf16* h0 = H + (size_t)(16 * t0 + i2) * D + kb2; bf16* h1 = H + (size_t)(16 * t1 + i2) * D + kb2; const GAS f32x4* gp = (const GAS f32x4*)(gain + kb2);
#pragma unroll
        for (int s = 0; s < 8; ++s) { const f32x4 ga = gp[8 * s], gb = gp[8 * s + 1];
            { const f32x4 a = xa[0][s][0], b = xa[0][s][1]; v4u o; o.x = cvtpk_hw(a.x * r0 * ga.x, a.y * r0 * ga.y); o.y = cvtpk_hw(a.z * r0 * ga.z, a.w * r0 * ga.w); o.z = cvtpk_hw(b.x * r0 * gb.x, b.y * r0 * gb.y); o.w = cvtpk_hw(b.z * r0 * gb.z, b.w * r0 * gb.w);
              *(v4u*)(h0 + 32 * s) = o; }
            { const f32x4 a = xa[1][s][0], b = xa[1][s][1]; v4u o; o.x = cvtpk_hw(a.x * r1 * ga.x, a.y * r1 * ga.y); o.y = cvtpk_hw(a.z * r1 * ga.z, a.w * r1 * ga.w); o.z = cvtpk_hw(b.x * r1 * gb.x, b.y * r1 * gb.y); o.w = cvtpk_hw(b.z * r1 * gb.z, b.w * r1 * gb.w);
              *(v4u*)(h1 + 32 * s) = o; } } }
    if (F.tid < 64) {
        int row = 0, e0 = 0, e1 = 0, q0 = 0, q1 = 0; float g0 = 0.f, g1 = 0.f;
        if (F.tid < 32) {
            row = (F.tid < 16 ? 16 * t0 : 16 * t1 - 16) + F.tid; const LAS float* lg = PS + F.tid * 48; const float rs = RSTD[F.tid];
            int gi = 0; float mg = lg[0] * rs;
#pragma unroll
            for (int j = 1; j < 4; ++j) { const float x = lg[j] * rs; if (x > mg) { mg = x; gi = j; } }
            float sg = 0.f;
#pragma unroll
            for (int j = 0; j < 4; ++j) sg += expf(lg[j] * rs - mg);
            const float pg = 1.0f / sg;
            const LAS float* le = lg + 4 + 8 * gi;
            int i0 = 0; float m0 = le[0] * rs;
#pragma unroll
            for (int j = 1; j < 8; ++j) { const float x = le[j] * rs; if (x > m0) { m0 = x; i0 = j; } }
            int i1 = -1; float m1 = -INFINITY;
#pragma unroll
            for (int j = 0; j < 8; ++j) { const float x = le[j] * rs; if (j != i0 && x > m1) { m1 = x; i1 = j; } }
            const float p1 = expf(m1 - m0), inv = 1.0f / (1.0f + p1);
            e0 = 8 * gi + i0; e1 = 8 * gi + i1; g0 = pg * inv; g1 = pg * p1 * inv;
            q0 = __hip_atomic_fetch_add(agg + e0, 1, __ATOMIC_RELAXED, __HIP_MEMORY_SCOPE_WORKGROUP);
            q1 = __hip_atomic_fetch_add(agg + e1, 1, __ATOMIC_RELAXED, __HIP_MEMORY_SCOPE_WORKGROUP);
        }
        LDS_WAIT();
        if (F.tid < 32) { const int c = agg[F.tid]; if (c > 0) agg[32 + F.tid] = (int)atomicAdd((unsigned*)(F.ctl + CW_CNT + layer * 2048) + F.tid * 64, (unsigned)c); }
        LDS_WAIT();
        if (F.tid < 32) {
            const int s0 = agg[32 + e0] + q0, s1 = agg[32 + e1] + q1;
            int* list = (int*)(F.ws + WS_LIST); int* tok = (int*)(F.ws + WS_TOK); float* gates = (float*)(F.ws + WS_TOK + 262144);
            list[e0 * 8192 + s0] = row; list[e1 * 8192 + s1] = row;
            tok[4 * row] = e0; tok[4 * row + 1] = s0; tok[4 * row + 2] = e1; tok[4 * row + 3] = s1;
            gates[2 * row] = g0; gates[2 * row + 1] = g1;
        }
    }
    WG_SYNC();
}
__device__ __forceinline__ void p0_norm_pair(Frame& F, const float* X, const float* gain, const float* w_in_ab, bf16* H, float* GB) {
    const int lane = F.lane, i = lane & 15, g = lane >> 4, w = F.wave;
    const int t0 = F.vcu, t1 = F.vcu + F.G;
    const int kb = 256 * w + 8 * g;
    const GAS f32x4* xr0 = (const GAS f32x4*)(X + (size_t)(16 * t0 + i) * D + kb); const GAS f32x4* xr1 = (const GAS f32x4*)(X + (size_t)(16 * t1 + i) * D + kb);
    f32x4 xa[2][8][2];
#pragma unroll
    for (int s = 0; s < 8; ++s) { xa[0][s][0] = xr0[8 * s]; xa[0][s][1] = xr0[8 * s + 1]; xa[1][s][0] = xr1[8 * s]; xa[1][s][1] = xr1[8 * s + 1]; }
    f32x4 acc[2] = {(f32x4){0.f, 0.f, 0.f, 0.f}, (f32x4){0.f, 0.f, 0.f, 0.f}}; float ss[2] = {0.f, 0.f};
    const GAS f32x4* gp = (const GAS f32x4*)(gain + kb);
#pragma unroll
    for (int s = 0; s < 8; ++s) { const int k0 = kb + 32 * s;
        if ((s & 1) == 0) asm volatile("" ::: "memory");
        const f32x4 ga = gp[8 * s], gb = gp[8 * s + 1];
        float wv[8];
#pragma unroll
        for (int j = 0; j < 8; ++j) wv[j] = w_in_ab[(size_t)(k0 + j) * NABX + NAB + i];
        wv[0] *= ga.x; wv[1] *= ga.y; wv[2] *= ga.z; wv[3] *= ga.w; wv[4] *= gb.x; wv[5] *= gb.y; wv[6] *= gb.z; wv[7] *= gb.w;
        v4u whi, wlo; whi.x = cvtpk_hw(wv[0], wv[1]); whi.y = cvtpk_hw(wv[2], wv[3]); whi.z = cvtpk_hw(wv[4], wv[5]); whi.w = cvtpk_hw(wv[6], wv[7]);
        wlo.x = cvtpk_hw(wv[0] - bflo(whi.x), wv[1] - bfhi(whi.x)); wlo.y = cvtpk_hw(wv[2] - bflo(whi.y), wv[3] - bfhi(whi.y)); wlo.z = cvtpk_hw(wv[4] - bflo(whi.z), wv[5] - bfhi(whi.z)); wlo.w = cvtpk_hw(wv[6] - bflo(whi.w), wv[7] - bfhi(whi.w));
        const bf16x8 bh = __builtin_bit_cast(bf16x8, whi), bl = __builtin_bit_cast(bf16x8, wlo);
#pragma unroll
        for (int rg = 0; rg < 2; ++rg) { const f32x4 a = xa[rg][s][0], b = xa[rg][s][1];
            ss[rg] += (a.x * a.x + a.y * a.y) + (a.z * a.z + a.w * a.w) + (b.x * b.x + b.y * b.y) + (b.z * b.z + b.w * b.w);
            v4u hi, lo; hi.x = cvtpk_hw(a.x, a.y); hi.y = cvtpk_hw(a.z, a.w); hi.z = cvtpk_hw(b.x, b.y); hi.w = cvtpk_hw(b.z, b.w);
            lo.x = cvtpk_hw(a.x - bflo(hi.x), a.y - bfhi(hi.x)); lo.y = cvtpk_hw(a.z - bflo(hi.y), a.w - bfhi(hi.y)); lo.z = cvtpk_hw(b.x - bflo(hi.z), b.y - bfhi(hi.z)); lo.w = cvtpk_hw(b.z - bflo(hi.w), b.w - bfhi(hi.w));
            const bf16x8 ah = __builtin_bit_cast(bf16x8, hi), al = __builtin_bit_cast(bf16x8, lo);
            acc[rg] = __builtin_amdgcn_mfma_f32_16x16x32_bf16(ah, bh, acc[rg], 0, 0, 0);
            acc[rg] = __builtin_amdgcn_mfma_f32_16x16x32_bf16(ah, bl, acc[rg], 0, 0, 0);
            acc[rg] = __builtin_amdgcn_mfma_f32_16x16x32_bf16(al, bh, acc[rg], 0, 0, 0); } }
    LAS float* PP = (LAS float*)(F.lds);
    LAS float* SS = (LAS float*)(F.lds + 16384);
    LAS float* RSTD = (LAS float*)(F.lds + 16384 + 1024);
#pragma unroll
    for (int rg = 0; rg < 2; ++rg) { float q = ss[rg]; q += __shfl_xor(q, 16); q += __shfl_xor(q, 32); if (g == 0) SS[w * 32 + 16 * rg + i] = q;
#pragma unroll
        for (int j = 0; j < 4; ++j) PP[((w * 2 + rg) * 16 + 4 * g + j) * 16 + i] = acc[rg][j]; }
    WG_SYNC();
    if (F.tid < 32) { float q = 0.f;
#pragma unroll
        for (int ww = 0; ww < 8; ++ww) q += SS[ww * 32 + F.tid];
        RSTD[F.tid] = 1.0f / sqrtf(q * (1.f / D) + EPS); }
    WG_SYNC();
    {   const int rg = F.tid >> 8, rc = F.tid & 255, tokl = rc >> 4; float q = 0.f;
#pragma unroll
        for (int ww = 0; ww < 8; ++ww) q += PP[(ww * 2 + rg) * 256 + rc];
        GB[(size_t)((rg ? 16 * t1 : 16 * t0) + tokl) * 16 + (rc & 15)] = q * RSTD[16 * rg + tokl]; }
    {   const float r0 = RSTD[i], r1 = RSTD[16 + i];
        bf16* h0 = H + (size_t)(16 * t0 + i) * D + kb; bf16* h1 = H + (size_t)(16 * t1 + i) * D + kb;
#pragma unroll
        for (int s = 0; s < 8; ++s) { const f32x4 ga = gp[8 * s], gb = gp[8 * s + 1];
            { const f32x4 a = xa[0][s][0], b = xa[0][s][1]; v4u o; o.x = cvtpk_hw(a.x * r0 * ga.x, a.y * r0 * ga.y); o.y = cvtpk_hw(a.z * r0 * ga.z, a.w * r0 * ga.w); o.z = cvtpk_hw(b.x * r0 * gb.x, b.y * r0 * gb.y); o.w = cvtpk_hw(b.z * r0 * gb.z, b.w * r0 * gb.w);
              *(v4u*)(h0 + 32 * s) = o; }
            { const f32x4 a = xa[1][s][0], b = xa[1][s][1]; v4u o; o.x = cvtpk_hw(a.x * r1 * ga.x, a.y * r1 * ga.y); o.y = cvtpk_hw(a.z * r1 * ga.z, a.w * r1 * ga.w); o.z = cvtpk_hw(b.x * r1 * gb.x, b.y * r1 * gb.y); o.w = cvtpk_hw(b.z * r1 * gb.z, b.w * r1 * gb.w);
              *(v4u*)(h1 + 32 * s) = o; } } }
    WG_SYNC();
}
__device__ __forceinline__ void moe_tables(Frame& F, int layer) {
    LAS int* cntL = (LAS int*)(F.lds + MOE_OFF); LAS int* ts = cntL + 32; LAS int* mte = ts + 33; LAS int* mts = mte + 96; LAS int* el = cntL + 257; LAS int* ll = cntL + 353; LAS int* cov = cntL + 451;
    if (F.tid < 32) {
        const int e = F.tid; const int c = (int)__hip_atomic_load(F.ctl + CW_CNT + layer * 2048 + e * 64, RLX_AGENT); cntL[e] = c; const int nt = (c + 255) >> 8;
        int incl = nt;
#pragma unroll
        for (int o = 1; o < 32; o <<= 1) { const int v = __shfl_up(incl, o); if (e >= o) incl += v; }
        const int excl = incl - nt; ts[e] = excl; if (e == 31) ts[32] = incl > 96 ? 96 : incl;
        for (int t = 0; t < nt; ++t) { if (excl + t < 96) { mte[excl + t] = e; mts[excl + t] = 256 * t; } }
    }
    if (F.tid < 384) cov[F.tid] = 0;
    WG_SYNC();
    const int U = ts[32] * 4;
    if (F.tid < 256 && F.tid < U) cov[pg8::xcd_remap(F.tid, U)] = 1;
    WG_SYNC();
    if (F.tid == 0) { int ne = 0, nl = 0; const int tm = ts[32];
        for (int mt = 0; mt < tm; ++mt) { if (cov[4 * mt] & cov[4 * mt + 1] & cov[4 * mt + 2] & cov[4 * mt + 3]) el[ne++] = mt; else ll[nl++] = mt; }
        cntL[449] = ne; cntL[450] = nl; }
    WG_SYNC();
}

__device__ __forceinline__ float fmac1(float d, float a, float b) { asm("v_fmac_f32_e32 %0, %1, %2" : "+v"(d) : "v"(a), "v"(b)); return d; }
#define R4_FMA4(A, S, W) do { (A).x = fmac1((A).x, (S), (W).x); (A).y = fmac1((A).y, (S), (W).y); (A).z = fmac1((A).z, (S), (W).z); (A).w = fmac1((A).w, (S), (W).w); } while (0)
template <bool COMBINE, int OUTMODE, int NG, class BSrc4, int NR = 4>
__device__ __forceinline__ void rows4(Frame& F, int r0, const float* xin, float* xout, const float* gain, bf16* H, float* OUT,
                                      const int* tokinfo, const float* gates, const bf16* ybuf, const LAS int* tstart, const BSrc4& bs, float* sel, const bf16* dl = nullptr) {
    const int lane = F.lane;
    f32x4 v[NR][8];
#pragma unroll
    for (int r = 0; r < NR; ++r) { const GAS f32x4* xr = (const GAS f32x4*)(xin + (size_t)(r0 + r) * D) + lane;
#pragma unroll
        for (int j = 0; j < 8; ++j) v[r][j] = xr[64 * j]; }
    if (COMBINE) {
        if (dl != nullptr)
#pragma unroll
        for (int r = 0; r < NR; ++r) { const GAS v2u* dr = (const GAS v2u*)(dl + (size_t)(r0 + r) * D) + lane;
#pragma unroll
            for (int j = 0; j < 8; ++j) { const v2u q = dr[64 * j]; v[r][j].x += bflo(q.x); v[r][j].y += bfhi(q.x); v[r][j].z += bflo(q.y); v[r][j].w += bfhi(q.y); } }
#pragma unroll
        for (int r = 0; r < NR; ++r) { const int row = r0 + r;
            const int e0 = tokinfo[4 * row], s0 = tokinfo[4 * row + 1], e1 = tokinfo[4 * row + 2], s1 = tokinfo[4 * row + 3];
            const float g0 = gates[2 * row], g1 = gates[2 * row + 1];
            const size_t q0 = (size_t)(tstart[e0] * 256 + s0), q1 = (size_t)(tstart[e1] * 256 + s1);
            const int odd = lane & 1; const size_t yo = (size_t)((lane >> 1) * 8 + 256 * odd);
            const GAS v4u* y0 = (const GAS v4u*)(ybuf + q0 * D + yo); const GAS v4u* y1 = (const GAS v4u*)(ybuf + q1 * D + yo);
#pragma unroll
            for (int t = 0; t < 4; ++t) { const v4u a = y0[64 * t], b = y1[64 * t];
                const unsigned ag0 = odd ? a.x : a.z, ag1 = odd ? a.y : a.w, bg0 = odd ? b.x : b.z, bg1 = odd ? b.y : b.w;
                const unsigned ar0 = (unsigned)__builtin_amdgcn_mov_dpp((int)ag0, 0xB1, 0xF, 0xF, true), ar1 = (unsigned)__builtin_amdgcn_mov_dpp((int)ag1, 0xB1, 0xF, 0xF, true);
                const unsigned br0 = (unsigned)__builtin_amdgcn_mov_dpp((int)bg0, 0xB1, 0xF, 0xF, true), br1 = (unsigned)__builtin_amdgcn_mov_dpp((int)bg1, 0xB1, 0xF, 0xF, true);
                const unsigned ae0 = odd ? ar0 : a.x, ae1 = odd ? ar1 : a.y, ao0 = odd ? a.z : ar0, ao1 = odd ? a.w : ar1;
                const unsigned be0 = odd ? br0 : b.x, be1 = odd ? br1 : b.y, bo0 = odd ? b.z : br0, bo1 = odd ? b.w : br1;
                { f32x4& w = v[r][2 * t]; w.x += g0 * bflo(ae0) + g1 * bflo(be0); w.y += g0 * bfhi(ae0) + g1 * bfhi(be0); w.z += g0 * bflo(ae1) + g1 * bflo(be1); w.w += g0 * bfhi(ae1) + g1 * bfhi(be1); }
                { f32x4& w = v[r][2 * t + 1]; w.x += g0 * bflo(ao0) + g1 * bflo(bo0); w.y += g0 * bfhi(ao0) + g1 * bfhi(bo0); w.z += g0 * bflo(ao1) + g1 * bflo(bo1); w.w += g0 * bfhi(ao1) + g1 * bfhi(bo1); } }
            if (OUTMODE == 0) { GAS f32x4* xo = (GAS f32x4*)(xout + (size_t)row * D) + lane;
#pragma unroll
                for (int j = 0; j < 8; ++j) xo[64 * j] = v[r][j]; } }
    }
    float rstd[NR];
#pragma unroll
    for (int r = 0; r < NR; ++r) { float s = 0.f;
#pragma unroll
        for (int j = 0; j < 8; ++j) s += (v[r][j].x * v[r][j].x + v[r][j].y * v[r][j].y) + (v[r][j].z * v[r][j].z + v[r][j].w * v[r][j].w);
        rstd[r] = 1.0f / sqrtf(wave_sum(s) * (1.f / D) + EPS); }
    { const GAS f32x4* gr = (const GAS f32x4*)gain + lane;
#pragma unroll
      for (int j = 0; j < 8; ++j) { const f32x4 g = gr[64 * j];
#pragma unroll
          for (int r = 0; r < NR; ++r) v[r][j] = v[r][j] * rstd[r] * g; } }
#pragma unroll
    for (int r = 0; r < NR; ++r) {
        if (OUTMODE == 0) { GAS v2u* o8 = (GAS v2u*)(H + (size_t)(r0 + r) * D) + lane;
#pragma unroll
            for (int j = 0; j < 8; ++j) { v2u o; o.x = pk2(v[r][j].x, v[r][j].y); o.y = pk2(v[r][j].z, v[r][j].w); o8[64 * j] = o; if (NG > 0) __builtin_amdgcn_sched_barrier(0); } }
        else { GAS f32x4* oo = (GAS f32x4*)(OUT + (size_t)(r0 + r) * D) + lane;
#pragma unroll
            for (int j = 0; j < 8; ++j) oo[64 * j] = v[r][j]; } }
    if (NG > 0) {
        static_assert(NG == 0 || NR == 4, "the skinny product is written for 4 rows");
        LAS float* ls = (LAS float*)(F.lds) + F.wave * 256;
#pragma unroll 1
        for (int g = 0; g < NG; ++g) {
            f32x4 acc[4];
#pragma unroll
            for (int r = 0; r < 4; ++r) acc[r] = (f32x4){0.f, 0.f, 0.f, 0.f};
            const GAS char* ub = (const GAS char*)bs.base(g); const unsigned st = bs.stride(g);
            unsigned vo = (unsigned)(4 * lane) * st; asm volatile("" : "+v"(vo));
#define R4_LD(j, q) (*(const GAS f32x4*)(ub + (size_t)((256u * (j) + (q)) * st) + vo))
#pragma unroll
            for (int j = 0; j < 8; ++j) {
                const f32x4 w0 = R4_LD(j, 0), w1 = R4_LD(j, 1), w2 = R4_LD(j, 2), w3 = R4_LD(j, 3);
#pragma unroll
                for (int r = 0; r < 4; ++r) { R4_FMA4(acc[r], v[r][j].x, w0); R4_FMA4(acc[r], v[r][j].y, w1); R4_FMA4(acc[r], v[r][j].z, w2); R4_FMA4(acc[r], v[r][j].w, w3); }
                asm volatile("" ::: "memory");
            }
#undef R4_LD
#pragma unroll
            for (int o = 1; o < 64; o <<= 1)
#pragma unroll
                for (int r = 0; r < 4; ++r) { acc[r].x += __shfl_xor(acc[r].x, o); acc[r].y += __shfl_xor(acc[r].y, o); acc[r].z += __shfl_xor(acc[r].z, o); acc[r].w += __shfl_xor(acc[r].w, o); }
            if (lane < 4) { const f32x4 m = lane == 0 ? acc[0] : (lane == 1 ? acc[1] : (lane == 2 ? acc[2] : acc[3])); *(LAS f32x4*)(ls + lane * 64 + 4 * g) = m; }
        }
        asm volatile("s_waitcnt lgkmcnt(0)" ::: "memory");
        if (lane < 4) {
#pragma unroll
            for (int i = 0; i < NG; ++i) { const f32x4 m = *(const LAS f32x4*)(ls + lane * 64 + 4 * i); sel[4 * i] = m.x; sel[4 * i + 1] = m.y; sel[4 * i + 2] = m.z; sel[4 * i + 3] = m.w; }
        }
    }
}
struct NoSrc4 { __device__ __forceinline__ const float* base(int) const { return nullptr; } __device__ __forceinline__ unsigned stride(int) const { return 0u; } };
struct GbSrc4 { const float* w; __device__ __forceinline__ const float* base(int g) const { return w + NAB + 4 * g; } __device__ __forceinline__ unsigned stride(int) const { return NABX * 4u; } };
struct RouterSrc4 { const float* wg; const float* we;
    __device__ __forceinline__ const float* base(int g) const { return g == 0 ? wg : we + 4 * (g - 1); } __device__ __forceinline__ unsigned stride(int g) const { return g == 0 ? 16u : 128u; } };

__device__ __forceinline__ void route_lane(Frame& F, int row, const float* sel, int layer) {
    int g = 0; float mg = sel[0];
#pragma unroll
    for (int j = 1; j < 4; ++j) { if (sel[j] > mg) { mg = sel[j]; g = j; } }
    float sg = 0.f;
#pragma unroll
    for (int j = 0; j < 4; ++j) sg += expf(sel[j] - mg);
    const float pg = 1.0f / sg;
    float le[8];
#pragma unroll
    for (int j = 0; j < 8; ++j) le[j] = g == 0 ? sel[4 + j] : (g == 1 ? sel[12 + j] : (g == 2 ? sel[20 + j] : sel[28 + j]));
    int i0 = 0; float m0 = le[0];
#pragma unroll
    for (int j = 1; j < 8; ++j) { if (le[j] > m0) { m0 = le[j]; i0 = j; } }
    int i1 = -1; float m1 = -INFINITY;
#pragma unroll
    for (int j = 0; j < 8; ++j) { if (j != i0 && le[j] > m1) { m1 = le[j]; i1 = j; } }
    const float p1 = expf(m1 - m0), inv = 1.0f / (1.0f + p1);
    const int e0 = 8 * g + i0, e1 = 8 * g + i1;
    unsigned* cnt = (unsigned*)(F.ctl + CW_CNT + layer * 2048);
    const int s0 = (int)atomicAdd(cnt + e0 * 64, 1u), s1 = (int)atomicAdd(cnt + e1 * 64, 1u);
    int* list = (int*)(F.ws + WS_LIST); int* tok = (int*)(F.ws + WS_TOK); float* gates = (float*)(F.ws + WS_TOK + 262144);
    list[e0 * 8192 + s0] = row; list[e1 * 8192 + s1] = row;
    tok[4 * row] = e0; tok[4 * row + 1] = s0; tok[4 * row + 2] = e1; tok[4 * row + 3] = s1;
    gates[2 * row] = pg * inv; gates[2 * row + 1] = pg * p1 * inv;
}

__device__ __forceinline__ bf16x8 frag16(const LAS bf16* X, int pitch, int row0, int k0, int lane) { return *(const LAS bf16x8*)(X + (row0 + (lane & 15)) * pitch + k0 + 8 * (lane >> 4)); }
#define MFMA16(a, b, c) __builtin_amdgcn_mfma_f32_16x16x32_bf16((a), (b), (c), 0, 0, 0)

struct GlaArgs { const float* w_gk; const float* b_gk; };
__device__ __forceinline__ float fexp(float x) { return __builtin_amdgcn_exp2f(x * 1.4426950408889634f); }
__device__ __forceinline__ float log_sigmoid(float x) { return fminf(x, 0.f) - 0.6931471805599453f * __builtin_amdgcn_logf(1.0f + fexp(-fabsf(x))); }
__device__ __forceinline__ void gla_a_unit(Frame& F, int unit, const GlaArgs& ga) {
    const int bh = unit >> 6, c = unit & 63, b = bh >> 2, h = bh & 3; const int row0 = b * SEQ + c * 64;
    const bf16* proj = (const bf16*)(F.ws + WS_PROJ); const float* gb = (const float*)(F.ws + WS_GB);
    bf16* GQ = (bf16*)(F.ws + WS_GQ); bf16* GK = (bf16*)(F.ws + WS_GK); float* DEC = (float*)(F.ws + WS_DEC); bf16* DS = (bf16*)(F.ws + WS_DS);
    LAS float* GBs = (LAS float*)(F.lds);
    LAS float* TOT = (LAS float*)(F.lds + 4096);
    LAS float* DECs = (LAS float*)(F.lds + 6144);
    LAS bf16* VT = (LAS bf16*)(F.lds + 8192);
    LAS bf16* KT = (LAS bf16*)(F.lds + 8192 + 36864);
    const int tid = F.tid;
    if (tid < 256) *(LAS f32x4*)(GBs + 4 * tid) = *(const GAS f32x4*)(gb + (size_t)row0 * 16 + 4 * tid);
    const int d = tid & 127, tq = tid >> 7;
    float wg[16];
#pragma unroll
    for (int r = 0; r < 16; ++r) wg[r] = ga.w_gk[r * 512 + h * 128 + d];
    const float bias = ga.b_gk[h * 128 + d];
    WG_SYNC();
    float bl[16]; float run = 0.f;
#pragma unroll
    for (int j = 0; j < 16; ++j) { const LAS float* g = GBs + (16 * tq + j) * 16; float x = bias;
#pragma unroll
        for (int r = 0; r < 16; ++r) x += g[r] * wg[r];
        run += log_sigmoid(x) * (1.0f / 16.0f); bl[j] = run; }
    TOT[tq * 128 + d] = run;
    WG_SYNC();
    float pre = 0.f, tot = 0.f;
#pragma unroll
    for (int q = 0; q < 4; ++q) { const float x = TOT[q * 128 + d]; tot += x; if (q < tq) pre += x; }
    if (tq == 0) { const float dc = fexp(tot); DECs[d] = dc; DEC[(size_t)(bh * 64 + c) * 128 + d] = dc; }
    unsigned kpk[8];
#pragma unroll
    for (int j = 0; j < 16; ++j) { const int t = 16 * tq + j; const size_t row = (size_t)(row0 + t);
        const float bb = pre + bl[j];
        const float q = bf2f(proj[row * NAB + C_QB + h * 128 + d]), k = bf2f(proj[row * NAB + C_KB + h * 128 + d]);
        const float qt = q * 0.08838834764831845f * fexp(bb), kt = k * fexp(-bb);
        const unsigned kb16 = f2bf(kt);
        GQ[row * 512 + h * 128 + d] = (bf16)f2bf(qt); GK[row * 512 + h * 128 + d] = (bf16)kb16;
        if (j & 1) kpk[j >> 1] |= kb16 << 16; else kpk[j >> 1] = kb16; }
    { LAS v4u* dst = (LAS v4u*)(KT + d * 72 + 16 * tq); dst[0] = (v4u){kpk[0], kpk[1], kpk[2], kpk[3]}; dst[1] = (v4u){kpk[4], kpk[5], kpk[6], kpk[7]}; }
    {
        const int e = tid & 255, th = tid >> 8; unsigned vp[16];
#pragma unroll
        for (int j = 0; j < 32; ++j) { const unsigned x = proj[(size_t)(row0 + 32 * th + j) * NAB + C_VB + h * 256 + e]; if (j & 1) vp[j >> 1] |= x << 16; else vp[j >> 1] = x; }
        LAS v4u* dst = (LAS v4u*)(VT + e * 72 + 32 * th);
#pragma unroll
        for (int q = 0; q < 4; ++q) dst[q] = (v4u){vp[4 * q], vp[4 * q + 1], vp[4 * q + 2], vp[4 * q + 3]};
    }
    WG_SYNC();
    {
        f32x4 acc[2][8];
#pragma unroll
        for (int mi = 0; mi < 2; ++mi)
#pragma unroll
            for (int ni = 0; ni < 8; ++ni) acc[mi][ni] = (f32x4){0.f, 0.f, 0.f, 0.f};
#pragma unroll
        for (int ks = 0; ks < 2; ++ks) {
            bf16x8 a[2]; a[0] = frag16(VT, 72, 16 * (2 * F.wave), 32 * ks, F.lane); a[1] = frag16(VT, 72, 16 * (2 * F.wave + 1), 32 * ks, F.lane);
#pragma unroll
            for (int ni = 0; ni < 8; ++ni) { const bf16x8 bq = frag16(KT, 72, 16 * ni, 32 * ks, F.lane); acc[0][ni] = MFMA16(bq, a[0], acc[0][ni]); acc[1][ni] = MFMA16(bq, a[1], acc[1][ni]); }
        }
        bf16* dsb = DS + ((size_t)(bh * 64 + c) << 15);
#pragma unroll
        for (int mi = 0; mi < 2; ++mi)
#pragma unroll
            for (int ni = 0; ni < 8; ++ni) { const int e = 16 * (2 * F.wave + mi) + (F.lane & 15), d0 = 16 * ni + 4 * (F.lane >> 4);
                const f32x4 dc = *(const LAS f32x4*)(DECs + d0); const f32x4 v = acc[mi][ni] * dc;
                v2u o; o.x = pk2(v.x, v.y); o.y = pk2(v.z, v.w); *(GAS v2u*)(dsb + e * 128 + d0) = o; }
    }
    WG_SYNC();
}

__device__ __forceinline__ void gla_scan(Frame& F) {
    const bf16* DS = (const bf16*)(F.ws + WS_DS); const float* DEC = (const float*)(F.ws + WS_DEC); bf16* ST = (bf16*)(F.ws + WS_ST);
    for (int el = (int)blockIdx.x * 512 + F.tid; el < 8 * 32768; el += F.G * 512) {
        const int bh = el >> 15, ed = el & 32767, d = el & 127; float S = 0.f;
#pragma unroll 8
        for (int c = 0; c < 64; ++c) { const size_t off = ((size_t)(bh * 64 + c) << 15) + ed; const float ds = bf2f(DS[off]), dc = DEC[(bh * 64 + c) * 128 + d];
            ST[off] = (bf16)f2bf(S); S = dc * S + ds; }
    }
}

__device__ __forceinline__ void gla_c_unit(Frame& F, int unit, const float* gnorm_g) {
    const int bh = unit >> 6, c = unit & 63, b = bh >> 2, h = bh & 3; const int row0 = b * SEQ + c * 64;
    const bf16* proj = (const bf16*)(F.ws + WS_PROJ); const bf16* GQ = (const bf16*)(F.ws + WS_GQ); const bf16* GK = (const bf16*)(F.ws + WS_GK);
    const bf16* ST = (const bf16*)(F.ws + WS_ST) + ((size_t)(bh * 64 + c) << 15); bf16* CAT = (bf16*)(F.ws + WS_CAT);
    LAS bf16* QT = (LAS bf16*)(F.lds);
    LAS bf16* KT = (LAS bf16*)(F.lds + 17408);
    LAS bf16* ATT = (LAS bf16*)(F.lds + 34816);
    LAS bf16* SH = (LAS bf16*)(F.lds + 44032);
    LAS bf16* VH = (LAS bf16*)(F.lds + 44032 + 34816);
    LAS float* OT = (LAS float*)(F.lds + 44032);
    const int tid = F.tid, lane = F.lane, w = F.wave;
#pragma unroll
    for (int i = 0; i < 2; ++i) { const int idx = tid + 512 * i, t = idx >> 4, ch = idx & 15;
        *(LAS v4u*)(QT + t * 136 + 8 * ch) = *(const GAS v4u*)(GQ + (size_t)(row0 + t) * 512 + h * 128 + 8 * ch);
        *(LAS v4u*)(KT + t * 136 + 8 * ch) = *(const GAS v4u*)(GK + (size_t)(row0 + t) * 512 + h * 128 + 8 * ch); }
    WG_SYNC();
    {
        const int mi = w >> 1; f32x4 a2[2] = {(f32x4){0.f, 0.f, 0.f, 0.f}, (f32x4){0.f, 0.f, 0.f, 0.f}};
#pragma unroll
        for (int ks = 0; ks < 4; ++ks) { const bf16x8 a = frag16(QT, 136, 16 * mi, 32 * ks, lane);
#pragma unroll
            for (int q = 0; q < 2; ++q) { const bf16x8 bq = frag16(KT, 136, 16 * (2 * (w & 1) + q), 32 * ks, lane); a2[q] = MFMA16(a, bq, a2[q]); } }
#pragma unroll
        for (int q = 0; q < 2; ++q)
#pragma unroll
            for (int j = 0; j < 4; ++j) { const int t = 16 * mi + 4 * (lane >> 4) + j, jj = 16 * (2 * (w & 1) + q) + (lane & 15); ATT[t * 72 + jj] = (bf16)f2bf(jj <= t ? a2[q][j] : 0.f); }
    }
    f32x4 acc[2][4];
#pragma unroll
    for (int H = 0; H < 2; ++H) {
        WG_SYNC();
#pragma unroll
        for (int i = 0; i < 4; ++i) { const int idx = tid + 512 * i, er = idx >> 4, ch = idx & 15;
            *(LAS v4u*)(SH + er * 136 + 8 * ch) = *(const GAS v4u*)(ST + (size_t)(128 * H + er) * 128 + 8 * ch); }
        { const int er = tid & 127, tq = tid >> 7; unsigned vp[8];
#pragma unroll
          for (int j = 0; j < 16; ++j) { const unsigned x = proj[(size_t)(row0 + 16 * tq + j) * NAB + C_VB + h * 256 + 128 * H + er]; if (j & 1) vp[j >> 1] |= x << 16; else vp[j >> 1] = x; }
          LAS v4u* dst = (LAS v4u*)(VH + er * 72 + 16 * tq); dst[0] = (v4u){vp[0], vp[1], vp[2], vp[3]}; dst[1] = (v4u){vp[4], vp[5], vp[6], vp[7]}; }
        WG_SYNC();
        const int mi = w & 3, nb = 4 * (w >> 2);
#pragma unroll
        for (int q = 0; q < 4; ++q) acc[H][q] = (f32x4){0.f, 0.f, 0.f, 0.f};
#pragma unroll
        for (int ks = 0; ks < 4; ++ks) { const bf16x8 a = frag16(QT, 136, 16 * mi, 32 * ks, lane);
#pragma unroll
            for (int q = 0; q < 4; ++q) { const bf16x8 bq = frag16(SH, 136, 16 * (nb + q), 32 * ks, lane); acc[H][q] = MFMA16(a, bq, acc[H][q]); } }
#pragma unroll
        for (int ks = 0; ks < 2; ++ks) { const bf16x8 a = frag16(ATT, 72, 16 * mi, 32 * ks, lane);
#pragma unroll
            for (int q = 0; q < 4; ++q) { const bf16x8 bq = frag16(VH, 72, 16 * (nb + q), 32 * ks, lane); acc[H][q] = MFMA16(a, bq, acc[H][q]); } }
    }
    WG_SYNC();
    { const int mi = w & 3, nb = 4 * (w >> 2);
#pragma unroll
      for (int H = 0; H < 2; ++H)
#pragma unroll
        for (int q = 0; q < 4; ++q)
#pragma unroll
            for (int j = 0; j < 4; ++j) OT[(16 * mi + 4 * (lane >> 4) + j) * 260 + 128 * H + 16 * (nb + q) + (lane & 15)] = acc[H][q][j]; }
    WG_SYNC();
    const f32x4 gg = *(const GAS f32x4*)(gnorm_g + 4 * lane);
#pragma unroll 2
    for (int i = 0; i < 8; ++i) { const int t = 8 * w + i; const size_t row = (size_t)(row0 + t);
        const f32x4 o = *(const LAS f32x4*)(OT + t * 260 + 4 * lane);
        const float ss = wave_sum((o.x * o.x + o.y * o.y) + (o.z * o.z + o.w * o.w)); const float rstd = 1.0f / sqrtf(ss * (1.f / 256.f) + EPS);
        const v2u rb = *(const GAS v2u*)(proj + row * NAB + C_RB + h * 256 + 4 * lane);
        const float r0 = bflo(rb.x), r1 = bfhi(rb.x), r2 = bflo(rb.y), r3 = bfhi(rb.y);
        const float s0 = r0 * __builtin_amdgcn_rcpf(1.f + fexp(-r0)), s1 = r1 * __builtin_amdgcn_rcpf(1.f + fexp(-r1)), s2 = r2 * __builtin_amdgcn_rcpf(1.f + fexp(-r2)), s3 = r3 * __builtin_amdgcn_rcpf(1.f + fexp(-r3));
        v2u out; out.x = pk2(o.x * rstd * gg.x * s0, o.y * rstd * gg.y * s1); out.y = pk2(o.z * rstd * gg.z * s2, o.w * rstd * gg.w * s3);
        *(GAS v2u*)(CAT + row * D + 1024 + h * 256 + 4 * lane) = out; }
    WG_SYNC();
}

__device__ __forceinline__ void attn_all(Frame& F, char* lds_generic) {
    const __hip_bfloat16* proj = (const __hip_bfloat16*)(F.ws + WS_PROJ); __hip_bfloat16* oraw = (__hip_bfloat16*)(F.ws + WS_ORAW);
    const int vv = F.vcu;
    const int bhm = vv >> 3, s = vv & 7, b = bhm >> 4, h = (bhm >> 1) & 7, m = bhm & 1;
    {
        const float* bt = (const float*)(F.ws + WS_BIAS) + h * 128;
        if (F.tid < 128) ((LAS float*)(F.lds + attn_body::LDS_TAB))[F.tid] = bt[F.tid];
        WG_SYNC();
    }
    const size_t rb = (size_t)b * SEQ;
#ifndef ATTN_REPS
#define ATTN_REPS 4
#endif
    for (int i = 0; i < ATTN_REPS; ++i) { const int vh = (i >> 1) & 1, qb = (i & 1) ? 15 - s : s;
        attn_body::attn_unit<8>(qb, proj + rb * NAB + C_QA + h * 128 + m * 64, proj + rb * NAB + C_KA + h * 128 + m * 64, proj + rb * NAB + C_VA + h * 128 + vh * 64,
                     oraw + rb * 2048 + m * 1024 + h * 128 + vh * 64, lds_generic); }
}

__device__ __forceinline__ void attn_all2(Frame& F, char* lds_generic) {
    const __hip_bfloat16* proj = (const __hip_bfloat16*)(F.ws + WS_PROJ); __hip_bfloat16* oraw = (__hip_bfloat16*)(F.ws + WS_ORAW);
    const int vv = F.vcu;
    const int bhm = vv >> 3, s = vv & 7, b = bhm >> 4, h = (bhm >> 1) & 7, m = bhm & 1;
    {   const float* bt = (const float*)(F.ws + WS_BIAS) + h * 128;
        if (F.tid < 128) ((LAS float*)(F.lds + attn_body::LDS2_TAB))[F.tid] = bt[F.tid];
        WG_SYNC();
    }
    const size_t rb = (size_t)b * SEQ;
    for (int i = 0; i < 2; ++i) { const int qb = i ? 15 - s : s;
        attn_body::attn_unit2<8>(qb, proj + rb * NAB + C_QA + h * 128 + m * 64, proj + rb * NAB + C_KA + h * 128 + m * 64, proj + rb * NAB + C_VA + h * 128,
                     oraw + rb * 2048 + m * 1024 + h * 128, lds_generic); }
}

__device__ __forceinline__ void diff_combine(Frame& F, const float* lam_vec, const float* subln_g) {
    const int gw = F.vcu * NWAVES + F.wave, NGW = F.G * NWAVES, lane = F.lane;
    const float s01 = wave_sum(lam_vec[lane] * lam_vec[64 + lane]), s23 = wave_sum(lam_vec[128 + lane] * lam_vec[192 + lane]);
    const float lam = expf(s01) - expf(s23) + 0.2f;
    const bf16* ORAW = (const bf16*)(F.ws + WS_ORAW); bf16* CAT = (bf16*)(F.ws + WS_CAT);
    float g[16];
#pragma unroll
    for (int i = 0; i < 16; ++i) g[i] = subln_g[(16 * lane + i) & 127] * 0.8f;
    for (int row = gw; row < T; row += NGW) {
        const GAS v4u* p0 = (const GAS v4u*)(ORAW + (size_t)row * 2048 + 16 * lane); const GAS v4u* p1 = (const GAS v4u*)(ORAW + (size_t)row * 2048 + 1024 + 16 * lane);
        const v4u a0 = p0[0], a1 = p0[1], b0 = p1[0], b1 = p1[1];
        const unsigned aw[8] = {a0.x, a0.y, a0.z, a0.w, a1.x, a1.y, a1.z, a1.w}, bw[8] = {b0.x, b0.y, b0.z, b0.w, b1.x, b1.y, b1.z, b1.w};
        float o[16]; float ss = 0.f;
#pragma unroll
        for (int i = 0; i < 8; ++i) { o[2 * i] = bflo(aw[i]) - lam * bflo(bw[i]); o[2 * i + 1] = bfhi(aw[i]) - lam * bfhi(bw[i]); ss += o[2 * i] * o[2 * i] + o[2 * i + 1] * o[2 * i + 1]; }
        ss += __shfl_xor(ss, 1); ss += __shfl_xor(ss, 2); ss += __shfl_xor(ss, 4);
        const float rstd = 1.0f / sqrtf(ss * (1.f / 128.f) + EPS);
        unsigned ow[8];
#pragma unroll
        for (int i = 0; i < 8; ++i) ow[i] = pk2(o[2 * i] * rstd * g[2 * i], o[2 * i + 1] * rstd * g[2 * i + 1]);
        GAS v4u* po = (GAS v4u*)(CAT + (size_t)row * D + 16 * lane); po[0] = (v4u){ow[0], ow[1], ow[2], ow[3]}; po[1] = (v4u){ow[4], ow[5], ow[6], ow[7]};
    }
}

struct SpArgs { const float *ln_g, *ln_b, *w_sp, *b_sp; };
__device__ __forceinline__ void spatial_unit(Frame& F, int unit, const SpArgs& sa) {
    const int g = unit & 7, cc = (unit >> 3) & 31, b = unit >> 8; const int row0 = b * SEQ + cc * 128;
    const bf16* UV = (const bf16*)(F.ws + WS_PROJ); bf16* CAT = (bf16*)(F.ws + WS_CAT); const float* stats = (const float*)(F.ws + WS_STATS);
    LAS bf16* WS = (LAS bf16*)(F.lds);
    LAS bf16* VN = (LAS bf16*)(F.lds + 34816);
    LAS bf16* ZS = (LAS bf16*)(F.lds + 34816);
    LAS float* MU = (LAS float*)(F.lds + 104448);
    LAS float* RS = MU + 128;
    const int tid = F.tid, lane = F.lane, w = F.wave;
    if (tid < 128) { const size_t row = (size_t)(row0 + tid); float s1 = 0.f, s2 = 0.f;
#pragma unroll
        for (int q = 0; q < 16; ++q) { const f32x4 p = *(const GAS f32x4*)(stats + row * 64 + 4 * q); s1 += p.x; s2 += p.y; s1 += p.z; s2 += p.w; }
        const float mu = s1 * (1.f / 2048.f);
        const float var = fmaxf(s2 * (1.f / 2048.f) - mu * mu, 0.f); MU[tid] = mu; RS[tid] = 1.0f / sqrtf(var + EPS); }
#pragma unroll
    for (int i = 0; i < 8; ++i) { const int idx = tid + 512 * i, t = idx >> 5, s4 = (idx & 31) * 4;
        const f32x4 x = *(const GAS f32x4*)(sa.w_sp + ((size_t)(g * 128 + t)) * 128 + s4);
        v2u o; o.x = pk2(s4 <= t ? x.x : 0.f, s4 + 1 <= t ? x.y : 0.f); o.y = pk2(s4 + 2 <= t ? x.z : 0.f, s4 + 3 <= t ? x.w : 0.f);
        *(LAS v2u*)(WS + t * 136 + s4) = o; }
    WG_SYNC();
    { const int col = tid & 255, sh = tid >> 8; const float lg = sa.ln_g[g * 256 + col], lb = sa.ln_b[g * 256 + col];
#pragma unroll 2
      for (int s8 = 0; s8 < 8; ++s8) { const int s0 = 64 * sh + 8 * s8; unsigned pk[4];
#pragma unroll
          for (int j = 0; j < 8; ++j) { const int s = s0 + j; const float v = bf2f(UV[(size_t)(row0 + s) * 4096 + 2048 + g * 256 + col]);
              const unsigned x = f2bf((v - MU[s]) * RS[s] * lg + lb); if (j & 1) pk[j >> 1] |= x << 16; else pk[j >> 1] = x; }
          *(LAS v4u*)(VN + col * 136 + s0) = (v4u){pk[0], pk[1], pk[2], pk[3]}; } }
    WG_SYNC();
    f32x4 acc[8][2];
#pragma unroll
    for (int mi = 0; mi < 8; ++mi) { acc[mi][0] = (f32x4){0.f, 0.f, 0.f, 0.f}; acc[mi][1] = (f32x4){0.f, 0.f, 0.f, 0.f}; }
#pragma unroll
    for (int ks = 0; ks < 4; ++ks) { const bf16x8 b0 = frag16(VN, 136, 16 * (2 * w), 32 * ks, lane), b1 = frag16(VN, 136, 16 * (2 * w + 1), 32 * ks, lane);
#pragma unroll
        for (int mi = 0; mi < 8; ++mi) if (mi >= 2 * ks) { const bf16x8 a = frag16(WS, 136, 16 * mi, 32 * ks, lane); acc[mi][0] = MFMA16(a, b0, acc[mi][0]); acc[mi][1] = MFMA16(a, b1, acc[mi][1]); } }
    WG_SYNC();
#pragma unroll
    for (int mi = 0; mi < 8; ++mi)
#pragma unroll
        for (int j = 0; j < 4; ++j) { const int t = 16 * mi + 4 * (lane >> 4) + j; const float bs = sa.b_sp[g * 128 + t];
#pragma unroll
            for (int q = 0; q < 2; ++q) ZS[t * 264 + 16 * (2 * w + q) + (lane & 15)] = (bf16)f2bf(acc[mi][q][j] + bs); }
    WG_SYNC();
#pragma unroll
    for (int i = 0; i < 8; ++i) { const int idx = tid + 512 * i, t = idx >> 5, ch = idx & 31;
        const v4u z = *(const LAS v4u*)(ZS + t * 264 + 8 * ch); const v4u u = *(const GAS v4u*)(UV + (size_t)(row0 + t) * 4096 + g * 256 + 8 * ch);
        v4u o; o.x = pk2(bflo(z.x) * bflo(u.x), bfhi(z.x) * bfhi(u.x)); o.y = pk2(bflo(z.y) * bflo(u.y), bfhi(z.y) * bfhi(u.y));
        o.z = pk2(bflo(z.z) * bflo(u.z), bfhi(z.z) * bfhi(u.z)); o.w = pk2(bflo(z.w) * bflo(u.w), bfhi(z.w) * bfhi(u.w));
        *(GAS v4u*)(CAT + (size_t)(row0 + t) * D + g * 256 + 8 * ch) = o; }
    WG_SYNC();
}

#if defined(DBG_NAIVE_ATTN)
__device__ __forceinline__ void dbg_attn(Frame& F, const float* lam_vec, const float* subln_g, const float* rel_bias) {
    const bf16* proj = (const bf16*)(F.ws + WS_PROJ); bf16* CAT = (bf16*)(F.ws + WS_CAT);
    LAS float* W = (LAS float*)(F.lds) + F.wave * 4096;
    const int gw = F.vcu * NWAVES + F.wave, NGW = F.G * NWAVES, lane = F.lane;
    const float s01 = wave_sum(lam_vec[lane] * lam_vec[64 + lane]), s23 = wave_sum(lam_vec[128 + lane] * lam_vec[192 + lane]);
    const float lam = expf(s01) - expf(s23) + 0.2f;
    for (int task = gw; task < 2 * 8 * SEQ; task += NGW) {
        const int b = task / (8 * SEQ), h = (task / SEQ) & 7, q = task % SEQ; const size_t rb = (size_t)b * SEQ;
        float o0 = 0.f, o1 = 0.f;
        for (int m = 0; m < 2; ++m) {
            float qv[64];
#pragma unroll
            for (int d = 0; d < 64; ++d) qv[d] = bf2f(proj[(rb + q) * NAB + C_QA + h * 128 + m * 64 + d]);
            float mx = -INFINITY;
            for (int j = lane; j <= q; j += 64) { const bf16* kr = proj + (rb + j) * NAB + C_KA + h * 128 + m * 64; float s = 0.f;
#pragma unroll
                for (int d = 0; d < 64; ++d) s += qv[d] * bf2f(kr[d]);
                const int rel = q - j; const int bk = rel < 128 ? (int)T5_BUCKET[rel] : 31; s += rel_bias[bk * 8 + h] * LOG2E; W[j] = s; mx = fmaxf(mx, s); }
#pragma unroll
            for (int o = 1; o < 64; o <<= 1) mx = fmaxf(mx, __shfl_xor(mx, o));
            float l = 0.f;
            for (int j = lane; j <= q; j += 64) { const float p = exp2f(W[j] - mx); W[j] = p; l += p; }
            l = wave_sum(l); LDS_WAIT();
            float a0 = 0.f, a1 = 0.f;
            for (int j = 0; j <= q; ++j) { const float p = W[j]; const unsigned vv = *(const unsigned*)(proj + (rb + j) * NAB + C_VA + h * 128 + 2 * lane); a0 += p * bflo(vv); a1 += p * bfhi(vv); }
            const float sc = (m == 0 ? 1.f : -lam) / l; o0 += sc * a0; o1 += sc * a1; LDS_WAIT();
        }
        const float ss = wave_sum(o0 * o0 + o1 * o1); const float rstd = 1.0f / sqrtf(ss * (1.f / 128.f) + EPS);
        *(unsigned*)(CAT + (rb + q) * D + h * 128 + 2 * lane) = pk2(o0 * rstd * subln_g[2 * lane] * 0.8f, o1 * rstd * subln_g[2 * lane + 1] * 0.8f);
    }
}
#endif
#if defined(DBG_NAIVE_GLA)
__device__ __forceinline__ void dbg_gla_rec(Frame& F, const float* w_gk, const float* b_gk) {
    const bf16* proj = (const bf16*)(F.ws + WS_PROJ); const float* gb = (const float*)(F.ws + WS_GB); float* OB = (float*)(F.ws + WS_DS);
    for (int task = F.vcu; task < 256; task += F.G) {
        const int bh = task >> 5, es = task & 31, b = bh >> 2, h = bh & 3;
        const int dh = F.wave & 1, eq = F.wave >> 1, d = dh * 64 + F.lane, e0 = es * 8 + 2 * eq;
        float wg[16];
#pragma unroll
        for (int r = 0; r < 16; ++r) wg[r] = w_gk[r * 512 + h * 128 + d];
        const float bias = b_gk[h * 128 + d];
        float s0 = 0.f, s1 = 0.f;
        for (int t = 0; t < SEQ; ++t) { const size_t row = (size_t)b * SEQ + t;
            float x = bias;
#pragma unroll
            for (int r = 0; r < 16; ++r) x += gb[row * 16 + r] * wg[r];
            const float a = expf(log_sigmoid(x) * (1.f / 16.f));
            const float k = bf2f(proj[row * NAB + C_KB + h * 128 + d]), q = bf2f(proj[row * NAB + C_QB + h * 128 + d]) * 0.08838834764831845f;
            const unsigned vv = *(const unsigned*)(proj + row * NAB + C_VB + h * 256 + e0);
            s0 = a * s0 + k * bflo(vv); s1 = a * s1 + k * bfhi(vv);
            const float p0 = wave_sum(q * s0), p1 = wave_sum(q * s1);
            if (F.lane == 0) { OB[((size_t)dh * T + row) * 1024 + h * 256 + e0] = p0; OB[((size_t)dh * T + row) * 1024 + h * 256 + e0 + 1] = p1; }
        }
    }
}
__device__ __forceinline__ void dbg_gla_norm(Frame& F, const float* gnorm_g) {
    const bf16* proj = (const bf16*)(F.ws + WS_PROJ); const float* OB = (const float*)(F.ws + WS_DS); bf16* CAT = (bf16*)(F.ws + WS_CAT);
    const int gw = F.vcu * NWAVES + F.wave, NGW = F.G * NWAVES, lane = F.lane;
    for (int task = gw; task < T * 4; task += NGW) { const int row = task >> 2, h = task & 3;
        float o[4]; float ss = 0.f;
#pragma unroll
        for (int i = 0; i < 4; ++i) { const int e = 4 * lane + i; o[i] = OB[(size_t)row * 1024 + h * 256 + e] + OB[((size_t)T + row) * 1024 + h * 256 + e]; ss += o[i] * o[i]; }
        const float rstd = 1.0f / sqrtf(wave_sum(ss) * (1.f / 256.f) + EPS);
#pragma unroll
        for (int i = 0; i < 4; ++i) { const int e = 4 * lane + i; const float r = bf2f(proj[(size_t)row * NAB + C_RB + h * 256 + e]);
            CAT[(size_t)row * D + 1024 + h * 256 + e] = (bf16)f2bf(o[i] * rstd * gnorm_g[e] * (r / (1.f + expf(-r)))); }
    }
}
#endif
#if defined(DBG_NAIVE_SPATIAL)
__device__ __forceinline__ void dbg_spatial(Frame& F, const float* ln_g, const float* ln_b, const float* w_sp, const float* b_sp) {
    const bf16* UV = (const bf16*)(F.ws + WS_PROJ); bf16* CAT = (bf16*)(F.ws + WS_CAT);
    LAS float* MU = (LAS float*)(F.lds); LAS float* RS = MU + 128;
    for (int task = F.vcu; task < 64; task += F.G) {
        const int row0 = task * 128;
        for (int i = 0; i < 16; ++i) { const int r = 16 * F.wave + i; float s1 = 0.f;
            for (int c = F.lane; c < 2048; c += 64) s1 += bf2f(UV[(size_t)(row0 + r) * 4096 + 2048 + c]);
            const float mu = wave_sum(s1) * (1.f / 2048.f); float s2 = 0.f;
            for (int c = F.lane; c < 2048; c += 64) { const float dlt = bf2f(UV[(size_t)(row0 + r) * 4096 + 2048 + c]) - mu; s2 += dlt * dlt; }
            const float var = wave_sum(s2) * (1.f / 2048.f);
            if (F.lane == 0) { MU[r] = mu; RS[r] = 1.0f / sqrtf(var + EPS); } }
        WG_SYNC();
        for (int ci = 0; ci < 4; ++ci) { const int col = F.tid + 512 * ci, g = col >> 8; const float lg = ln_g[col], lb = ln_b[col];
            for (int t = 0; t < 128; ++t) { float z = b_sp[g * 128 + t];
                for (int s = 0; s <= t; ++s) z += w_sp[(size_t)(g * 128 + t) * 128 + s] * ((bf2f(UV[(size_t)(row0 + s) * 4096 + 2048 + col]) - MU[s]) * RS[s] * lg + lb);
                CAT[(size_t)(row0 + t) * D + col] = (bf16)f2bf(z * bf2f(UV[(size_t)(row0 + t) * 4096 + col])); } }
        WG_SYNC();
    }
}
#endif

enum { I_X = 0, I_RELB, I_NMIX, I_NFFN, I_NFIN, I_WINAB, I_LAM, I_SUBLN, I_WGK, I_BGK, I_GNORM, I_WOUTAB, I_WINC, I_LNG, I_LNB, I_WSP, I_BSP, I_WOUTC, I_WRG, I_WRE, I_WEG, I_WEU, I_WED, N_IN };
struct Args { const float* in[N_IN]; float* out; unsigned char* ws; int ph_lo, ph_hi; };

__device__ __forceinline__ const float* argp(const Args& a, int i) { asm volatile("" : "+s"(i)); return a.in[i]; }
__device__ __forceinline__ void moe_up_setup(Frame& F, pg8::MoeProb<true>& P, int layer) {
    const LAS int* base = (const LAS int*)(F.lds + MOE_OFF);
    P.A = (const bf16*)(F.ws + WS_H); P.Bt = (const bf16*)(F.ws + WS_WGU) + (size_t)layer * NEXP * 1024 * D; P.K = D; P.NPN = 4; P.bstride = (size_t)1024 * D * 2;
    P.U = base[64] * 4; P.lcount = P.U; P.l1 = 1 << 28; P.lstride = 0; P.use_list = false; P.split = false; P.split_base = 0; P.cnt = base; P.mt_e = base + 65; P.mt_s0 = base + 161; P.mlist = base + 257; P.list = (const int*)(F.ws + WS_LIST);
}
__device__ __forceinline__ void moe_down_setup(Frame& F, pg8::MoeProb<false>& P, int layer) {
    const LAS int* base = (const LAS int*)(F.lds + MOE_OFF);
    P.A = (const bf16*)(F.ws + WS_ACT); P.Bt = (const bf16*)(F.ws + WS_WDN) + (size_t)layer * NEXP * D * FF; P.K = FF; P.NPN = 8; P.bstride = (size_t)D * FF * 2;
    P.U = base[64] * 8; P.use_list = true; P.split = false; P.split_base = 0; P.l1 = 1 << 28; P.lstride = 0; P.cnt = base; P.mt_e = base + 65; P.mt_s0 = base + 161; P.list = (const int*)(F.ws + WS_LIST);
}
template <class Prob>
__device__ __forceinline__ void moe_wait_units(Frame& F, const Prob& P, int layer) {
    if (F.wave == 0) {
        gu32* cw = F.ctl + CW_MOEUP + layer * 96 * MOEUP_STRIDE; pg8::Unit u; bool any = false;
        for (int i = 0; P.next(i, u); ++i) { any = true; unsigned spins = 0;
            while (__builtin_amdgcn_readfirstlane(__hip_atomic_load(cw + u.pm * MOEUP_STRIDE, __ATOMIC_RELAXED, __HIP_MEMORY_SCOPE_AGENT)) < 32u) { __builtin_amdgcn_s_sleep(1); if (++spins > (1u << 20)) break; } }
        if (any) { __builtin_amdgcn_fence(__ATOMIC_ACQUIRE, "agent"); asm volatile("s_waitcnt vmcnt(0)" ::: "memory"); }
    }
    WG_SYNC();
}
__device__ __forceinline__ void moe_phase_a(Frame& F, int layer) {
    pg8::MoeProb<true> P; moe_up_setup(F, P, layer); P.l0 = (int)blockIdx.x;
    pg8::EpiSwiglu E{(bf16*)(F.ws + WS_ACT), FF, (unsigned*)(F.ctl + CW_MOEUP + layer * 96 * MOEUP_STRIDE)};
    pg8::gemm_phase<pg8::EpiSwiglu, pg8::MoeProb<true>, true>(F.lds + RING_OFF, P, E);
}
__device__ __forceinline__ void moe_phase_b(Frame& F, int layer) {
    const LAS int* base = (const LAS int*)(F.lds + MOE_OFF);
    const int U = base[64] * 4, G = F.G, n_heavy = U > G ? U - G : 0, c = (int)blockIdx.x, HU = 2 * n_heavy;
    constexpr bool splitmode = false;
    const int nh = splitmode ? HU : n_heavy;
    if (c < nh) {
        pg8::MoeProb<true> P; moe_up_setup(F, P, layer);
        if (splitmode) { P.split = true; P.split_base = G; P.l0 = c; P.lcount = HU; } else { P.l0 = G + c; }
        pg8::EpiSwiglu E{(bf16*)(F.ws + WS_ACT), FF, (unsigned*)(F.ctl + CW_MOEUP + layer * 96 * MOEUP_STRIDE)};
        if (!splitmode) pg8::gemm_phase<pg8::EpiSwiglu, pg8::MoeProb<true>, true>(F.lds + RING_OFF, P, E);
        else if (c & 1) pg8::gemm_phase<pg8::EpiSwiglu, pg8::MoeProb<true>, true, 2>(F.lds + RING_OFF, P, E);
        else pg8::gemm_phase<pg8::EpiSwiglu, pg8::MoeProb<true>, true, 1>(F.lds + RING_OFF, P, E);
    }
    {
        pg8::MoeProb<false> P; moe_down_setup(F, P, layer); P.mlist = base + 257; P.lcount = 8 * base[449];
        if (splitmode) { P.l0 = c; if (c >= nh) { P.l1 = G + (c - nh); P.lstride = G - nh; } }
        else { if (c >= nh) { P.l0 = c - nh; P.l1 = P.l0 + (G - nh); P.lstride = G - nh; } else P.l0 = 1 << 28; }
        pg8::EpiBf16M E{(bf16*)(F.ws + WS_PROJ), D};
        if (!MK_PER_PHASE) moe_wait_units(F, P, layer);
        pg8::gemm_phase<pg8::EpiBf16M, pg8::MoeProb<false>, true>(F.lds + RING_OFF, P, E);
    }
}
__device__ __forceinline__ void moe_phase_c(Frame& F, int layer) {
    const LAS int* base = (const LAS int*)(F.lds + MOE_OFF);
    pg8::MoeProb<false> P; moe_down_setup(F, P, layer); P.mlist = base + 353; P.l0 = (int)blockIdx.x; P.l1 = P.l0 + F.G; P.lstride = F.G; P.lcount = 8 * base[450];
    pg8::EpiBf16M E{(bf16*)(F.ws + WS_PROJ), D};
    if (!MK_PER_PHASE) moe_wait_units(F, P, layer);
    pg8::gemm_phase<pg8::EpiBf16M, pg8::MoeProb<false>, true>(F.lds + RING_OFF, P, E);
}

__global__ void __launch_bounds__(NWAVES * 64, 2) fwd_kernel(Args args) {
    extern __shared__ __attribute__((aligned(16))) unsigned char lds[];
    Frame F;
    F.lds = (LAS unsigned char*)lds;
    F.tid = threadIdx.x; F.lane = F.tid & 63; F.wave = __builtin_amdgcn_readfirstlane(F.tid >> 6);
    F.G = gridDim.x; { const int bx = blockIdx.x; F.vcu = (F.G % 8 == 0) ? (bx % 8) * (F.G / 8) + bx / 8 : bx; }
    F.ws = args.ws; F.ctl = (gu32*)(args.ws + WS_CTL);
    for (int u = F.tid; u < (LDS_BYTES - LDSCTL_OFF) / 4; u += NWAVES * 64) ((LAS unsigned*)(F.lds + LDSCTL_OFF))[u] = 0u;
    __syncthreads();
    XcdBarrier bar; bar.bar = (unsigned*)(F.ctl + CW_BAR); bar.x = 0; bar.st = nullptr;
    if (!MK_PER_PHASE) bar = xcd_barrier_post((unsigned*)(F.ctl + CW_BAR), (volatile LAS unsigned*)(F.lds + MISC_OFF));
    const int lo = args.ph_lo, hi = args.ph_hi;
#ifndef PH_MASK
#define PH_MASK 0xfffff
#endif
#ifndef REPEAT_MASK
#define REPEAT_MASK 0
#endif
#define IN(k) (((PH_MASK >> (k)) & 1) && lo <= (k) && (k) < hi)
#define REP(k) for (int rep_ = 0; rep_ < ((((REPEAT_MASK) >> (k)) & 1) ? 2 : 1); ++rep_)
#define RETID() do { int t_ = threadIdx.x; asm volatile("" : "+v"(t_)); F.tid = t_; F.lane = t_ & 63; } while (0)
#ifndef BAR_REPS
#define BAR_REPS 1
#endif
#define SEAM(k) do { RETID(); if (IN(k) && IN((k) + 1)) { for (int br_ = 0; br_ < BAR_REPS; ++br_) xcd_barrier(bar); } } while (0)
#define SEAM_NB(k) do { RETID(); if (MK_PER_PHASE && IN(k) && IN((k) + 1)) xcd_barrier(bar); } while (0)
#define ARG(i) argp(args, (i))
    const LAS int* tstart = (const LAS int*)(F.lds + MOE_OFF) + 32;

    if (IN(0)) REP(0) {
        P0Args pa{ARG(I_WINAB), ARG(I_WOUTAB), ARG(I_WINC), ARG(I_WOUTC), ARG(I_WEG), ARG(I_WEU), ARG(I_WED), ARG(I_RELB)};
        p0_convert(F, pa, P0_I_AB);
        p0_router_weights(F, ARG(I_WRG), ARG(I_WRE), ARG(I_NFFN));
        WG_SYNC();
        p0_norm_pair(F, ARG(I_X), ARG(I_NMIX), ARG(I_WINAB), (bf16*)(F.ws + WS_H), (float*)(F.ws + WS_GB));
    }
    SEAM(0);
#ifndef NCONV
#define NCONV 16
#endif
    if (IN(1)) {
        P0Args pa{ARG(I_WINAB), ARG(I_WOUTAB), ARG(I_WINC), ARG(I_WOUTC), ARG(I_WEG), ARG(I_WEU), ARG(I_WED), ARG(I_RELB)};
        const int xcd = F.vcu >> 5, li = F.vcu & 31;
        if (li < NCONV) { p0_convert_stream(F, pa, xcd); WG_SYNC(); }
        {   pg8::QueueProb P; P.init((const bf16*)(F.ws + WS_H), (const bf16*)(F.ws + WS_WAB), T, NAB, D, xcd, (unsigned*)(F.ctl + CW_QGEMM + xcd * 64), (volatile LAS int*)(F.lds + MISC_OFF + 32));
            P.prime(); WG_SYNC();
            pg8::EpiBf16S E{(bf16*)(F.ws + WS_PROJ), NAB, 0.125f * LOG2E, 1024};
            pg8::gemm_phase<pg8::EpiBf16S, pg8::QueueProb, true>(F.lds + RING_OFF, P, E); }
        RETID();
        if (li >= NCONV) { WG_SYNC(); p0_convert_stream(F, pa, xcd); }
    }
    SEAM(1);
#if defined(DBG_NAIVE_GLA)
    if (IN(2)) REP(2) dbg_gla_rec(F, ARG(I_WGK), ARG(I_BGK));
    SEAM(2);
    if (IN(3)) REP(3) dbg_gla_norm(F, ARG(I_GNORM));
#else
    if (IN(2)) REP(2) { const GlaArgs ga{ARG(I_WGK), ARG(I_BGK)}; for (int u = F.vcu; u < 512; u += F.G) gla_a_unit(F, u, ga); }
    SEAM(2);
    if (IN(3)) REP(3) gla_scan(F);
#endif
    SEAM(3);
    if (IN(4)) REP(4) {
#if !defined(DBG_NAIVE_GLA)
        for (int r2_ = 0; r2_ < ((((REPEAT_MASK) >> 19) & 1) ? 2 : 1); ++r2_)
        for (int u = F.vcu; u < 512; u += F.G) gla_c_unit(F, u, ARG(I_GNORM));
#endif
#if defined(DBG_NAIVE_ATTN)
        dbg_attn(F, ARG(I_LAM), ARG(I_SUBLN), ARG(I_RELB));
#else
        for (int r2_ = 0; r2_ < ((((REPEAT_MASK) >> 18) & 1) ? 2 : 1); ++r2_)
#if defined(ATTN_V64)
        attn_all(F, (char*)lds + RING_OFF);
#else
        attn_all2(F, (char*)lds + RING_OFF);
#endif
#endif
    }
    SEAM(4);
#if !defined(DBG_NAIVE_ATTN)
    if (IN(5)) REP(5) diff_combine(F, ARG(I_LAM), ARG(I_SUBLN));
#endif
    SEAM(5);
    if (IN(6)) REP(6) {
        pg8::DenseProb P; P.init((const bf16*)(F.ws + WS_CAT), (const bf16*)(F.ws + WS_WOAB), T, D, D, F.G, (int)blockIdx.x);
        pg8::EpiRes E{ARG(I_X), (float*)(F.ws + WS_X), D};
        pg8::gemm_phase<pg8::EpiRes, pg8::DenseProb, false>(F.lds + RING_OFF, P, E);
    }
    SEAM(6);
#define ROUTER_PHASE(layer) do { const bf16* WH_ = (const bf16*)(F.ws + WS_WR) + (size_t)(layer) * 2 * 48 * D; \
        router_pair(F, (layer), ((layer) || !0) ? (const float*)(F.ws + WS_X) : ARG(I_X), ((layer) ? 1 : 0) ? (const bf16*)(F.ws + WS_ORAW) : (const bf16*)nullptr, ARG(I_NFFN) + (size_t)(layer) * D, (bf16*)(F.ws + WS_H), WH_, WH_ + (size_t)48 * D); } while (0)
    if (IN(7)) REP(7) ROUTER_PHASE(0);
    SEAM(7);
    if (IN(8)) REP(8) { moe_tables(F, 0); moe_phase_a(F, 0); }
    SEAM_NB(8);
    if (IN(9)) REP(9) { if (MK_PER_PHASE) moe_tables(F, 0); moe_phase_b(F, 0); }
    SEAM_NB(9);
    if (IN(10)) REP(10) { if (MK_PER_PHASE) moe_tables(F, 0); moe_phase_c(F, 0); }
    SEAM(10);
    if (IN(11)) REP(11) {
        if (MK_PER_PHASE) moe_tables(F, 0);
        for (int b2 = F.vcu * NWAVES + F.wave; b2 < T / 2; b2 += F.G * NWAVES)
            rows4<true, 0, 0, NoSrc4, 2>(F, 2 * b2, (const float*)(F.ws + WS_X), (float*)(F.ws + WS_X), ARG(I_NMIX) + D, (bf16*)(F.ws + WS_H), nullptr,
                                      (const int*)(F.ws + WS_TOK), (const float*)(F.ws + WS_TOK + 262144), (const bf16*)(F.ws + WS_PROJ), tstart, NoSrc4{}, nullptr, (const bf16*)nullptr);
    }
    SEAM(11);
    if (IN(12)) REP(12) {
        pg8::DenseProb P; P.init((const bf16*)(F.ws + WS_H), (const bf16*)(F.ws + WS_WINC), T, 2 * D, D, F.G, (int)blockIdx.x);
        pg8::EpiGelu E{(bf16*)(F.ws + WS_PROJ), 2 * D, (float*)(F.ws + WS_STATS), D};
        pg8::gemm_phase<pg8::EpiGelu, pg8::DenseProb, true>(F.lds + RING_OFF, P, E);
    }
    SEAM(12);
#if defined(DBG_NAIVE_SPATIAL)
    if (IN(13)) REP(13) dbg_spatial(F, ARG(I_LNG), ARG(I_LNB), ARG(I_WSP), ARG(I_BSP));
#else
    if (IN(13)) REP(13) { const SpArgs sa{ARG(I_LNG), ARG(I_LNB), ARG(I_WSP), ARG(I_BSP)}; for (int u = F.vcu; u < 512; u += F.G) spatial_unit(F, u, sa); }
#endif
    SEAM(13);
    if (IN(14)) REP(14) {
        pg8::DenseProb P; P.init((const bf16*)(F.ws + WS_CAT), (const bf16*)(F.ws + WS_WOC), T, D, D, F.G, (int)blockIdx.x);
        pg8::EpiBf16S E{(bf16*)(F.ws + WS_ORAW), D, 1.f, 0};
        pg8::gemm_phase<pg8::EpiBf16S, pg8::DenseProb, true>(F.lds + RING_OFF, P, E);
    }
    SEAM(14);
    if (IN(15)) REP(15) ROUTER_PHASE(1);
    SEAM(15);
    if (IN(16)) REP(16) { moe_tables(F, 1); moe_phase_a(F, 1); }
    SEAM_NB(16);
    if (IN(17)) REP(17) { if (MK_PER_PHASE) moe_tables(F, 1); moe_phase_b(F, 1); }
    SEAM_NB(17);
    if (IN(18)) REP(18) { if (MK_PER_PHASE) moe_tables(F, 1); moe_phase_c(F, 1); }
    SEAM(18);
    if (IN(19)) REP(19) {
        if (MK_PER_PHASE) moe_tables(F, 1);
        for (int b2 = F.vcu * NWAVES + F.wave; b2 < T / 2; b2 += F.G * NWAVES)
            rows4<true, 1, 0, NoSrc4, 2>(F, 2 * b2, (const float*)(F.ws + WS_X), nullptr, ARG(I_NFIN), nullptr, args.out,
                                      (const int*)(F.ws + WS_TOK), (const float*)(F.ws + WS_TOK + 262144), (const bf16*)(F.ws + WS_PROJ), tstart, NoSrc4{}, nullptr, (const bf16*)(F.ws + WS_ORAW));
    }
#undef IN
#undef SEAM
#undef ROUTER_PHASE
#undef ARG
}

extern "C" void kernel_launch(void* const* d_in, const int* in_sizes, int n_in, void* d_out, int out_size, void* d_ws, size_t ws_size, hipStream_t stream) {
    static int grid = 0;
    if (grid == 0) {
        if (n_in != N_IN || in_sizes[0] != T * D || out_size != T * D || ws_size < WS_END) {
            fprintf(stderr, "kernel_launch: built for %d inputs, x/out of %d floats, >= %zu bytes of workspace; got n_in %d, in0 %d, out %d, ws %zu; nothing launched\n", (int)N_IN, T * D, (size_t)WS_END, n_in, n_in > 0 ? in_sizes[0] : -1, out_size, ws_size);
            grid = -1; return; }
        int dev = 0, cus = 0, per_cu = 0;
        if (hipGetDevice(&dev) != hipSuccess || hipDeviceGetAttribute(&cus, hipDeviceAttributeMultiprocessorCount, dev) != hipSuccess) { fprintf(stderr, "kernel_launch: device query failed\n"); grid = -1; return; }
        if (hipFuncSetAttribute((const void*)fwd_kernel, hipFuncAttributeMaxDynamicSharedMemorySize, LDS_BYTES) != hipSuccess) { fprintf(stderr, "kernel_launch: hipFuncSetAttribute failed\n"); grid = -1; return; }
        if (hipOccupancyMaxActiveBlocksPerMultiprocessor(&per_cu, (const void*)fwd_kernel, NWAVES * 64, LDS_BYTES) != hipSuccess || per_cu < 1)
            fprintf(stderr, "kernel_launch: note: occupancy query reports %d workgroups per CU\n", per_cu);
        (void)hipGetLastError();
        grid = cus;
        if (grid != 256) { fprintf(stderr, "kernel_launch: this kernel needs a 256-CU device (got %d)\n", cus); grid = -1; return; }
    }
    if (grid < 0) return;
    if (hipMemsetAsync((char*)d_ws + WS_CTL, 0, CTL_ZERO_BYTES, stream) != hipSuccess) { fprintf(stderr, "kernel_launch: hipMemsetAsync failed\n"); return; }
    Args a{};
    for (int i = 0; i < N_IN; ++i) a.in[i] = (const float*)d_in[i];
    a.out = (float*)d_out; a.ws = (unsigned char*)d_ws;
#if MK_PER_PHASE
    for (int p = 0; p < NPHASE; ++p) { a.ph_lo = p; a.ph_hi = p + 1; hipLaunchKernelGGL(fwd_kernel, dim3(grid), dim3(NWAVES * 64), LDS_BYTES, stream, a); }
#else
    a.ph_lo = 0; a.ph_hi = NPHASE; hipLaunchKernelGGL(fwd_kernel, dim3(grid), dim3(NWAVES * 64), LDS_BYTES, stream, a);
#endif
    const hipError_t le = hipPeekAtLastError();
    if (le != hipSuccess) fprintf(stderr, "kernel_launch: launch failed: %s\n", hipGetErrorName(le));
}
```

```cpp
#include <hip/hip_runtime.h>
#include <hip/hip_bf16.h>
#include <cstdio>
#include <cstdint>
#include <cmath>

namespace pg8 {
#define PG8_LAS __attribute__((address_space(3)))
typedef unsigned short bf16_t;
typedef short bf16x8 __attribute__((ext_vector_type(8)));
typedef float f32x4 __attribute__((ext_vector_type(4)));
typedef unsigned u32x4 __attribute__((ext_vector_type(4)));
constexpr int BM = 256, BK = 64, HALF = 128, HTB = HALF * BK * 2  , STAGE_BYTES = 8 * HTB, NXCD = 8, WGM = 8;

__host__ __device__ __forceinline__ int lds_byte(int r, int c) { const int st = (r >> 4) * 2 + (c >> 5), rr = r & 15, cc = c & 31, ob = rr * 64 + cc * 2; return st * 1024 + (ob ^ (((ob >> 9) & 1) << 5)); }
__host__ __device__ __forceinline__ void stage_rc(int b, int& R, int& C) { const int st = b / 1024, sb = b % 1024, swz = sb ^ (((sb >> 9) & 1) << 5); R = (st >> 1) * 16 + swz / 64; C = (st & 1) * 32 + (swz % 64) / 2; }
__host__ __device__ __forceinline__ int perm32(int rho) { const int n = rho >> 4, i = rho & 15; return 8 * (i >> 2) + 4 * n + (i & 3); }

struct Unit { int pm, pn, e, s0, cnt, half; };

__device__ __forceinline__ unsigned cvt_pk_bf16(float lo, float hi) { unsigned r; asm volatile("v_cvt_pk_bf16_f32 %0, %1, %2" : "=v"(r) : "v"(lo), "v"(hi)); return r; }

struct QueueProb {
    static constexpr bool GATHER = false;
    const bf16_t* A; const bf16_t* Bt; int K, nM, nN, per, xcd; unsigned* ctr; volatile PG8_LAS int* slot;
    __device__ void init(const bf16_t* A_, const bf16_t* Bt_, int M, int N, int K_, int xcd_, unsigned* ctr_, volatile PG8_LAS int* slot_) { A = A_; Bt = Bt_; K = K_; nM = M / BM; nN = N / BM; per = nM * nN / NXCD; xcd = xcd_; ctr = ctr_; slot = slot_; }
    __device__ __forceinline__ void prime() const {
        if (threadIdx.x == 0) { slot[0] = (int)__hip_atomic_fetch_add(ctr, 1u, __ATOMIC_RELAXED, __HIP_MEMORY_SCOPE_AGENT); slot[1] = (int)__hip_atomic_fetch_add(ctr, 1u, __ATOMIC_RELAXED, __HIP_MEMORY_SCOPE_AGENT); } }
    __device__ __forceinline__ bool next(int i, Unit& u) const {
        const int j3 = i % 3; const int t = __builtin_amdgcn_readfirstlane(slot[j3]);
        if (i > 0 && threadIdx.x == 0) slot[j3 == 2 ? 0 : j3 + 1] = (int)__hip_atomic_fetch_add(ctr, 1u, __ATOMIC_RELAXED, __HIP_MEMORY_SCOPE_AGENT);
        if (t >= per) return false;
        const int wgid = xcd * per + t;
        const int nig = WGM * nN, gid = wgid / nig, fm = gid * WGM, gsz = (nM - fm) < WGM ? (nM - fm) : WGM;
        u.pm = fm + ((wgid % nig) % gsz); u.pn = (wgid % nig) / gsz; u.e = 0; u.s0 = 0; u.cnt = 0; u.half = 0; return true;
    }
    __device__ __forceinline__ const char* a_base(const Unit& u) const { return (const char*)A + (size_t)u.pm * BM * K * 2; }
    __device__ __forceinline__ const char* b_base(const Unit& u) const { return (const char*)Bt + (size_t)u.pn * BM * K * 2; }
    __device__ __forceinline__ unsigned a_row(const Unit&, int r) const { return (unsigned)r * (unsigned)K * 2u; }
};
struct DenseProb {
    static constexpr bool GATHER = false;
    const bf16_t* A; const bf16_t* Bt; int K, nM, nN, nwg, G, c;
    __device__ void init(const bf16_t* A_, const bf16_t* Bt_, int M, int N, int K_, int G_, int c_) { A = A_; Bt = Bt_; K = K_; nM = M / BM; nN = N / BM; nwg = nM * nN; G = G_; c = c_; }
    __device__ __forceinline__ bool next(int i, Unit& u) const {
        const long L = (long)i * G + c; if (L >= nwg) return false;
        int wgid = (int)L; { const int q = nwg / NXCD, r = nwg % NXCD, xcd = wgid % NXCD, off = wgid / NXCD; wgid = (xcd < r ? xcd * (q + 1) : r * (q + 1) + (xcd - r) * q) + off; }
        const int nig = WGM * nN, gid = wgid / nig, fm = gid * WGM, gsz = (nM - fm) < WGM ? (nM - fm) : WGM;
        u.pm = fm + ((wgid % nig) % gsz); u.pn = (wgid % nig) / gsz; u.e = 0; u.s0 = 0; u.cnt = 0; u.half = 0; return true;
    }
    __device__ __forceinline__ const char* a_base(const Unit& u) const { return (const char*)A + (size_t)u.pm * BM * K * 2; }
    __device__ __forceinline__ const char* b_base(const Unit& u) const { return (const char*)Bt + (size_t)u.pn * BM * K * 2; }
    __device__ __forceinline__ unsigned a_row(const Unit&, int r) const { return (unsigned)r * (unsigned)K * 2u; }
};
__device__ __forceinline__ int xcd_remap(int L, int U) { const int q = U / NXCD, r = U % NXCD, xcd = L % NXCD, off = L / NXCD; return (xcd < r ? xcd * (q + 1) : r * (q + 1) + (xcd - r) * q) + off; }
template <bool GATHER_> struct MoeProb {
    static constexpr bool GATHER = GATHER_;
    const bf16_t* A; const bf16_t* Bt; int K, NPN; size_t bstride;
    int l0, l1, lstride, lcount, U, split_base; bool use_list, split;
    const PG8_LAS int* mt_e; const PG8_LAS int* mt_s0; const PG8_LAS int* cnt; const PG8_LAS int* mlist; const int* list;
    __device__ __forceinline__ bool next(int i, Unit& u) const {
        int L = i == 0 ? l0 : l1 + (i - 1) * lstride; if (i > 64 || L >= lcount) return false;
        u.half = 0; if (split) { u.half = 1 + (L & 1); L = split_base + (L >> 1); }
        if (use_list) { u.pm = mlist[L / NPN]; u.pn = L % NPN; } else { const int w = xcd_remap(L, U); u.pm = w / NPN; u.pn = w % NPN; }
        u.e = mt_e[u.pm]; u.s0 = mt_s0[u.pm]; u.cnt = cnt[u.e]; return true;
    }
    __device__ __forceinline__ const char* a_base(const Unit& u) const { return GATHER ? (const char*)A : (const char*)A + (size_t)u.pm * BM * K * 2; }
    __device__ __forceinline__ const char* b_base(const Unit& u) const { return (const char*)Bt + (size_t)u.e * bstride + (size_t)u.pn * BM * K * 2; }
    __device__ __forceinline__ unsigned a_row(const Unit& u, int r) const {
        if (!GATHER) return (unsigned)r * (unsigned)K * 2u;
        const int slot = u.s0 + r; const int tok = slot < u.cnt ? list[u.e * 8192 + slot] : 0; return (unsigned)tok * (unsigned)K * 2u;
    }
};

struct EpiBf16S {
    static constexpr bool PERM = true;
    bf16_t* O; int ldc; float scale0; int scale_cols;
    __device__ __forceinline__ void operator()(const f32x4 (&acc)[2][2][4][2], const Unit& u, int wr, int wc, int fr, int fq) const {
        const int row0 = u.pm * BM + wr * 64 + fr, colt = u.pn * BM; const float sc = colt < scale_cols ? scale0 : 1.f;
        const int col0 = colt + wc * 32 + 8 * fq;
#pragma unroll
        for (int ai = 0; ai < 2; ++ai) { if (u.half == 2 - ai) continue;
#pragma unroll
            for (int m = 0; m < 4; ++m) { bf16_t* rowp = O + (size_t)(row0 + ai * HALF + m * 16) * ldc + col0;
#pragma unroll
                for (int bj = 0; bj < 2; ++bj) { const f32x4 v0 = acc[ai][bj][m][0] * sc, v1 = acc[ai][bj][m][1] * sc;
                    u32x4 w; w.x = cvt_pk_bf16(v0[0], v0[1]); w.y = cvt_pk_bf16(v0[2], v0[3]); w.z = cvt_pk_bf16(v1[0], v1[1]); w.w = cvt_pk_bf16(v1[2], v1[3]);
                    *(u32x4*)(rowp + bj * HALF) = w; } } }
    }
};
struct EpiBf16M {
    static constexpr bool PERM = true;
    bf16_t* O; int ldc;
    __device__ __forceinline__ void operator()(const f32x4 (&acc)[2][2][4][2], const Unit& u, int wr, int wc, int fr, int fq) const {
        const int row0 = u.pm * BM + wr * 64 + fr, col0 = u.pn * BM + wc * 32 + 8 * fq, left = u.cnt - u.s0 - wr * 64 - fr;
#pragma unroll
        for (int ai = 0; ai < 2; ++ai) { if (u.half == 2 - ai) continue;
#pragma unroll
            for (int m = 0; m < 4; ++m) { if (ai * HALF + m * 16 >= left) continue;
                bf16_t* rowp = O + (size_t)(row0 + ai * HALF + m * 16) * ldc + col0;
#pragma unroll
                for (int bj = 0; bj < 2; ++bj) { const f32x4 v0 = acc[ai][bj][m][0], v1 = acc[ai][bj][m][1];
                    u32x4 w; w.x = cvt_pk_bf16(v0[0], v0[1]); w.y = cvt_pk_bf16(v0[2], v0[3]); w.z = cvt_pk_bf16(v1[0], v1[1]); w.w = cvt_pk_bf16(v1[2], v1[3]);
                    *(u32x4*)(rowp + bj * HALF) = w; } } }
    }
};
struct EpiRes {
    static constexpr bool PERM = false;
    const float* base; float* out; int ldc;
    __device__ __forceinline__ void operator()(const f32x4 (&acc)[2][2][4][2], const Unit& u, int wr, int wc, int fr, int fq) const {
        const int row0 = u.pm * BM + wr * 64 + fr, col0 = u.pn * BM + wc * 32 + 4 * fq;
        f32x4 cur[2][2], nxt[2][2];
#define ER_LOAD(dst, g) do { const size_t off_ = (size_t)(row0 + ((g) >> 2) * HALF + ((g) & 3) * 16) * ldc + col0; \
        _Pragma("unroll") for (int bj = 0; bj < 2; ++bj) _Pragma("unroll") for (int n = 0; n < 2; ++n) dst[bj][n] = *(const f32x4*)(base + off_ + bj * HALF + n * 16); } while (0)
        ER_LOAD(cur, 0);
#pragma unroll
        for (int g = 0; g < 8; ++g) { const int ai = g >> 2, m = g & 3; const size_t off = (size_t)(row0 + ai * HALF + m * 16) * ldc + col0;
            if (g < 7) ER_LOAD(nxt, g + 1);
#pragma unroll
            for (int bj = 0; bj < 2; ++bj)
#pragma unroll
                for (int n = 0; n < 2; ++n) *(f32x4*)(out + off + bj * HALF + n * 16) = cur[bj][n] + acc[ai][bj][m][n];
#pragma unroll
            for (int bj = 0; bj < 2; ++bj)
#pragma unroll
                for (int n = 0; n < 2; ++n) cur[bj][n] = nxt[bj][n];
            asm volatile("" ::: "memory"); }
#undef ER_LOAD
    }
};
__device__ __forceinline__ float gelu_tanh(float x) {
    const float u2 = x * (1.5957691216057308f + 0.07135481282052917f * x * x);
    return x * __builtin_amdgcn_rcpf(1.0f + __builtin_amdgcn_exp2f(-1.4426950408889634f * u2));
}
struct EpiGelu {
    static constexpr bool PERM = true;
    bf16_t* O; int ldc; float* stats; int stat_col0;
    __device__ __forceinline__ void operator()(const f32x4 (&acc)[2][2][4][2], const Unit& u, int wr, int wc, int fr, int fq) const {
        const int row0 = u.pm * BM + wr * 64 + fr, colt = u.pn * BM; const bool st = colt >= stat_col0;
        const int col0 = colt + wc * 32 + 8 * fq;
#pragma unroll
        for (int ai = 0; ai < 2; ++ai)
#pragma unroll
            for (int m = 0; m < 4; ++m) { const int row = row0 + ai * HALF + m * 16; bf16_t* rowp = O + (size_t)row * ldc + col0; float s1 = 0.f, s2 = 0.f;
#pragma unroll
                for (int bj = 0; bj < 2; ++bj) { f32x4 v0 = acc[ai][bj][m][0], v1 = acc[ai][bj][m][1];
#pragma unroll
                    for (int j = 0; j < 4; ++j) { v0[j] = gelu_tanh(v0[j]); v1[j] = gelu_tanh(v1[j]); s1 += v0[j] + v1[j]; s2 += v0[j] * v0[j] + v1[j] * v1[j]; }
                    u32x4 w; w.x = cvt_pk_bf16(v0[0], v0[1]); w.y = cvt_pk_bf16(v0[2], v0[3]); w.z = cvt_pk_bf16(v1[0], v1[1]); w.w = cvt_pk_bf16(v1[2], v1[3]);
                    *(u32x4*)(rowp + bj * HALF) = w; }
                if (st) { s1 += __shfl_xor(s1, 16); s1 += __shfl_xor(s1, 32); s2 += __shfl_xor(s2, 16); s2 += __shfl_xor(s2, 32);
                    if (fq == 0) { typedef float f32x2s __attribute__((ext_vector_type(2))); *(f32x2s*)(stats + ((size_t)row * 32 + ((colt - stat_col0) >> 8) * 4 + wc) * 2) = (f32x2s){s1, s2}; } } }
    }
};
struct EpiSwiglu {
    static constexpr bool PERM = true;
    bf16_t* O; int ldc; unsigned* done;
    __device__ __forceinline__ void operator()(const f32x4 (&acc)[2][2][4][2], const Unit& u, int wr, int wc, int fr, int fq) const {
        const int row0 = u.pm * BM + wr * 64 + fr, col0 = u.pn * HALF + wc * 32 + 8 * fq;
        const __amdgpu_buffer_rsrc_t rsrc = __builtin_amdgcn_make_buffer_rsrc(O, 0, 24576 * 512 * 2, 0x00020000);
#pragma unroll
        for (int ai = 0; ai < 2; ++ai) { if (u.half == 2 - ai) continue;
#pragma unroll
            for (int m = 0; m < 4; ++m) { const unsigned boff = (unsigned)((row0 + ai * HALF + m * 16) * ldc + col0) * 2u; f32x4 r[2];
#pragma unroll
                for (int n = 0; n < 2; ++n)
#pragma unroll
                    for (int j = 0; j < 4; ++j) { const float g = acc[ai][0][m][n][j], up = acc[ai][1][m][n][j];
                        r[n][j] = g * __builtin_amdgcn_rcpf(1.0f + __builtin_amdgcn_exp2f(-1.4426950408889634f * g)) * up; }
                u32x4 w; w.x = cvt_pk_bf16(r[0][0], r[0][1]); w.y = cvt_pk_bf16(r[0][2], r[0][3]); w.z = cvt_pk_bf16(r[1][0], r[1][1]); w.w = cvt_pk_bf16(r[1][2], r[1][3]);
                __builtin_amdgcn_raw_buffer_store_b128(w, rsrc, (int)boff, 0,   16); } }
        asm volatile("s_waitcnt vmcnt(0)" ::: "memory");
        if (fr == 0 && fq == 0) __hip_atomic_fetch_add(done + u.pm * 8, 1u, __ATOMIC_RELAXED, __HIP_MEMORY_SCOPE_AGENT);
    }
};

template <class Epi, class Prob, bool ALIGN_EPI, int HM = 0>
__device__ __forceinline__ void gemm_phase(PG8_LAS unsigned char* lds, const Prob& P, const Epi& E) {
    int tid_ = threadIdx.x; asm volatile("" : "+v"(tid_));
    const int tid = tid_, wid = __builtin_amdgcn_readfirstlane(tid >> 6), lane = tid & 63, wr = wid >> 2, wc = wid & 3, fr = lane & 15, fq = lane >> 4;
    const int K = P.K, nt = K / BK;
    int R0, C0, R1, C1; stage_rc(tid * 16, R0, C0); stage_rc(tid * 16 + 8192, R1, C1);
    const int Rb0 = Epi::PERM ? ((R0 & ~31) + perm32(R0 & 31)) : R0, Rb1 = Epi::PERM ? ((R1 & ~31) + perm32(R1 & 31)) : R1;
    const unsigned voffB0 = (unsigned)(Rb0 * K + C0) * 2u, voffB1 = (unsigned)(Rb1 * K + C1) * 2u;
    const unsigned colA0 = (unsigned)C0 * 2u, colA1 = (unsigned)C1 * 2u;
    const size_t kstep = (size_t)(BK * 2);
    const size_t hstep = (size_t)HALF * K * 2;
    const unsigned ldsw = (unsigned)wid * 1024u;
    const int aoff = lds_byte(wr * 64 + fr, fq * 8), boff = lds_byte(wc * 32 + fr, fq * 8);
#define PG8_SA(b, h) (((b) * 2 + (h)) * HTB)
#define PG8_SB(b, h) ((4 + (b) * 2 + (h)) * HTB)
#define PG8_STAGE2(bufoff, gbase, o0, o1) do { \
        __builtin_amdgcn_global_load_lds((const unsigned*)((const char*)(gbase) + (o0)), (PG8_LAS unsigned*)(lds + (bufoff) + ldsw), 16, 0, 0); \
        __builtin_amdgcn_global_load_lds((const unsigned*)((const char*)(gbase) + (o1)), (PG8_LAS unsigned*)(lds + (bufoff) + ldsw + 8192), 16, 0, 0); } while (0)
#define PG8_STAGEB(bufoff, gbase) PG8_STAGE2(bufoff, gbase, voffB0, voffB1)
#define PG8_LDA(dst, b, h) do { _Pragma("unroll") for (int m = 0; m < 4; ++m) _Pragma("unroll") for (int k = 0; k < 2; ++k) dst[m][k] = *(const PG8_LAS bf16x8*)(lds + PG8_SA(b, h) + aoff + m * 2048 + k * 1024); } while (0)
#define PG8_LDB(dst, b, h) do { _Pragma("unroll") for (int n = 0; n < 2; ++n) _Pragma("unroll") for (int k = 0; k < 2; ++k) dst[n][k] = *(const PG8_LAS bf16x8*)(lds + PG8_SB(b, h) + boff + n * 2048 + k * 1024); } while (0)
#define PG8_MMA(ai, bj, At, Bt) do { __builtin_amdgcn_s_setprio(1); _Pragma("unroll") for (int m = 0; m < 4; ++m) _Pragma("unroll") for (int n = 0; n < 2; ++n) _Pragma("unroll") for (int k = 0; k < 2; ++k) \
        acc[ai][bj][m][n] = __builtin_amdgcn_mfma_f32_16x16x32_bf16(Bt[n][k], At[m][k], acc[ai][bj][m][n], 0, 0, 0); __builtin_amdgcn_s_setprio(0); } while (0)
#define PG8_WAIT_V(n) asm volatile("s_waitcnt vmcnt(" #n ")" ::: "memory")
#define PG8_WAIT_L(n) asm volatile("s_waitcnt lgkmcnt(" #n ")" ::: "memory")
#define PG8_BAR __builtin_amdgcn_s_barrier()
#define PG8_SCHED __builtin_amdgcn_sched_barrier(0)
    Unit cur, nxt; int ui = 0;
    if (!P.next(0, cur)) return;
    f32x4 acc[2][2][4][2];
#pragma unroll
    for (int a = 0; a < 2; ++a)
#pragma unroll
        for (int b = 0; b < 2; ++b)
#pragma unroll
            for (int m = 0; m < 4; ++m)
#pragma unroll
                for (int n = 0; n < 2; ++n) acc[a][b][m][n] = (f32x4){0.f, 0.f, 0.f, 0.f};
    bf16x8 At[4][2], B0[2][2], B1[2][2];
    const char* cA = P.a_base(cur); const char* cB = P.b_base(cur);
    unsigned cv00 = P.a_row(cur, R0) + colA0, cv01 = P.a_row(cur, R1) + colA1, cv10 = P.a_row(cur, HALF + R0) + colA0, cv11 = P.a_row(cur, HALF + R1) + colA1;
    PG8_STAGEB(PG8_SB(0, 0), cB); PG8_STAGEB(PG8_SB(0, 1), cB + hstep); PG8_STAGE2(PG8_SA(0, 0), cA, cv00, cv01); PG8_STAGE2(PG8_SA(0, 1), cA, cv10, cv11);
    if (wr == 1) PG8_BAR;
    PG8_WAIT_V(2); PG8_BAR;
    PG8_STAGEB(PG8_SB(1, 0), cB + kstep); PG8_STAGE2(PG8_SA(1, 0), cA + kstep, cv00, cv01); PG8_STAGEB(PG8_SB(1, 1), cB + hstep + kstep);
    PG8_WAIT_V(6); PG8_BAR;
    for (;;) {
        const bool has_next = P.next(ui + 1, nxt);
        const char* nA = has_next ? P.a_base(nxt) : cA; const char* nB = has_next ? P.b_base(nxt) : cB;
        unsigned nv00 = cv00, nv01 = cv01, nv10 = cv10, nv11 = cv11;
        if (Prob::GATHER && has_next) { nv00 = P.a_row(nxt, R0) + colA0; nv01 = P.a_row(nxt, R1) + colA1; nv10 = P.a_row(nxt, HALF + R0) + colA0; nv11 = P.a_row(nxt, HALF + R1) + colA1; }
        constexpr bool DO0 = HM != 2, DO1 = HM != 1;
        for (int t = 0; t < nt; t += 2) {
            const bool last = (t == nt - 2);
            const char* a1 = cA + (size_t)(t + 1) * kstep;
            const char* a2 = last ? nA : cA + (size_t)(t + 2) * kstep; const char* b2 = last ? nB : cB + (size_t)(t + 2) * kstep;
            const char* a3 = a2 + kstep; const char* b3 = b2 + kstep;
            const unsigned s00 = (Prob::GATHER && last) ? nv00 : cv00, s01 = (Prob::GATHER && last) ? nv01 : cv01, s10 = (Prob::GATHER && last) ? nv10 : cv10, s11 = (Prob::GATHER && last) ? nv11 : cv11;
            PG8_LDB(B0, 0, 0); PG8_LDB(B1, 0, 1); PG8_SCHED; if (DO0) PG8_LDA(At, 0, 0); PG8_STAGE2(PG8_SA(1, 1), a1, cv10, cv11);
            PG8_WAIT_V(8); PG8_WAIT_L(0); PG8_BAR; if (DO0) { PG8_MMA(0, 0, At, B0); PG8_MMA(0, 1, At, B1); } PG8_BAR; PG8_SCHED;
            if (DO1) PG8_LDA(At, 0, 1); PG8_STAGEB(PG8_SB(0, 0), b2); PG8_STAGEB(PG8_SB(0, 1), b2 + hstep); PG8_STAGE2(PG8_SA(0, 0), a2, s00, s01);
            PG8_WAIT_V(8); PG8_WAIT_L(0); PG8_BAR; if (DO1) { PG8_MMA(1, 0, At, B0); PG8_MMA(1, 1, At, B1); } PG8_BAR; PG8_SCHED;
            PG8_LDB(B0, 1, 0); PG8_LDB(B1, 1, 1); PG8_SCHED; if (DO0) PG8_LDA(At, 1, 0); PG8_STAGE2(PG8_SA(0, 1), a2, s10, s11);
            PG8_WAIT_V(8); PG8_WAIT_L(0); PG8_BAR; if (DO0) { PG8_MMA(0, 0, At, B0); PG8_MMA(0, 1, At, B1); } PG8_BAR; PG8_SCHED;
            if (DO1) PG8_LDA(At, 1, 1); PG8_STAGEB(PG8_SB(1, 0), b3); PG8_STAGEB(PG8_SB(1, 1), b3 + hstep); PG8_STAGE2(PG8_SA(1, 0), a3, s00, s01);
            PG8_WAIT_V(8); PG8_WAIT_L(0); PG8_BAR; if (DO1) { PG8_MMA(1, 0, At, B0); PG8_MMA(1, 1, At, B1); } PG8_BAR; PG8_SCHED;
        }
        if constexpr (ALIGN_EPI) { if (wr == 0) PG8_BAR; }
        E(acc, cur, wr, wc, fr, fq);
        if (!has_next) break;
#pragma unroll
        for (int a = 0; a < 2; ++a)
#pragma unroll
            for (int b = 0; b < 2; ++b)
#pragma unroll
                for (int m = 0; m < 4; ++m)
#pragma unroll
                    for (int n = 0; n < 2; ++n) acc[a][b][m][n] = (f32x4){0.f, 0.f, 0.f, 0.f};
        cur = nxt; cA = nA; cB = nB; ++ui; cv00 = nv00; cv01 = nv01; cv10 = nv10; cv11 = nv11;
        if constexpr (ALIGN_EPI) { if (wr == 1) PG8_BAR; }
    }
    PG8_WAIT_V(0);
    if constexpr (!ALIGN_EPI) { if (wr == 0) PG8_BAR; }
    PG8_BAR;
#undef PG8_SA
#undef PG8_SB
#undef PG8_STAGE2
#undef PG8_STAGEB
#undef PG8_LDA
#undef PG8_LDB
#undef PG8_MMA
#undef PG8_WAIT_V
#undef PG8_WAIT_L
#undef PG8_BAR
#undef PG8_SCHED
}
}
namespace attn_body {
using bf16=__hip_bfloat16;
using bf16x8=__attribute__((ext_vector_type(8)))short;
using s16x4=__attribute__((ext_vector_type(4)))short;
using f32x16=__attribute__((ext_vector_type(16)))float;
using u32x4=__attribute__((ext_vector_type(4)))unsigned;
constexpr int SEQ=4096,D=64,PQ=6144,PO=2048;
constexpr int NW=8,QBLK=32,QB=QBLK*NW,KVBLK=64,NQB=SEQ/QB;
__device__ __forceinline__ int crow(int r,int hi){return (r&3)+8*(r>>2)+4*hi;}
#define SBAR() __builtin_amdgcn_sched_barrier(0)
typedef __attribute__((address_space(3))) const float* lds_cfptr;
__device__ __forceinline__ void cmask(f32x16&p0,f32x16&p1,int jb,int qrel,int hi,lds_cfptr tab){
  const float NEG=-INFINITY; const int rb=qrel-64*jb-4*hi;
  #pragma unroll
  for(int g=0;g<4;++g){
    #pragma unroll
    for(int q=0;q<4;++q){const int r=4*g+q; const int rel0=rb-(q+8*g), rel1=rel0-32;
      const int i0=rel0<0?0:(rel0>127?127:rel0), i1=rel1<0?0:(rel1>127?127:rel1);
      const float b0=tab[i0], b1=tab[i1];
      p0[r]=rel0<0?NEG:p0[r]+b0; p1[r]=rel1<0?NEG:p1[r]+b1;}
    asm volatile("":"+v"(p0),"+v"(p1)); SBAR();
  }
}

constexpr int NSLOT=3, SLOTB=8192;
constexpr int LDS_K=0, LDS_V=NSLOT*SLOTB, LDS_WS=2*NSLOT*SLOTB, LDS_OST=LDS_WS+NW*64*4, LDS_TAB=LDS_OST+NW*4096, LDS_BYTES=LDS_TAB+512;
constexpr float C2=0.125f*1.4426950408889634f;
__device__ __forceinline__ void glds16(const void*gsrc,unsigned lds_dst){unsigned keep;
  asm volatile("s_mov_b32 %0, m0\n\ts_mov_b32 m0, %2\n\ts_nop 0\n\tglobal_load_lds_dwordx4 %1, off\n\ts_mov_b32 m0, %0":"=&s"(keep):"v"(gsrc),"s"(lds_dst):"memory");}
__device__ __forceinline__ float max3f(float a,float b,float c){float r;asm("v_max3_f32 %0, %1, %2, %3":"=v"(r):"v"(a),"v"(b),"v"(c));return r;}
__device__ __forceinline__ float max2f(float a,float b){float r;asm("v_max_f32_e32 %0, %1, %2":"=v"(r):"v"(a),"v"(b));return r;}
__device__ __forceinline__ float fadd_s(float a,float b){float r;asm("v_add_f32_e32 %0, %1, %2":"=v"(r):"v"(a),"v"(b));return r;}
__device__ __forceinline__ float fsub_s(float a,float b){float r;asm("v_sub_f32_e32 %0, %1, %2":"=v"(r):"v"(a),"v"(b));return r;}
typedef float f32x2_t __attribute__((ext_vector_type(2))); typedef __bf16 bf16x2_t __attribute__((ext_vector_type(2)));
__device__ __forceinline__ unsigned cvtpk_s(float lo,float hi){f32x2_t v={lo,hi};bf16x2_t b=__builtin_convertvector(v,bf16x2_t);return __builtin_bit_cast(unsigned,b);}
#define WAIT_BAR(N) asm volatile("s_waitcnt vmcnt(" #N ") lgkmcnt(0)\n\ts_barrier":::"memory")

__device__ __forceinline__ void qkt(f32x16&p0,f32x16&p1,const char*Kslot,const bf16x8*qr,const f32x16&negm,int r32,int hi){
  const char*kb=Kslot+hi*1024+r32*16;
  #pragma unroll
  for(int d0=0;d0<4;++d0){
    const bf16x8 b0=*reinterpret_cast<const bf16x8*>(kb+d0*2048);
    const bf16x8 b1=*reinterpret_cast<const bf16x8*>(kb+d0*2048+512);
    if(d0==0){p0=__builtin_amdgcn_mfma_f32_32x32x16_bf16(b0,qr[0],negm,0,0,0);p1=__builtin_amdgcn_mfma_f32_32x32x16_bf16(b1,qr[0],negm,0,0,0);}
    else{p0=__builtin_amdgcn_mfma_f32_32x32x16_bf16(b0,qr[d0],p0,0,0,0);p1=__builtin_amdgcn_mfma_f32_32x32x16_bf16(b1,qr[d0],p1,0,0,0);}}
}
typedef __attribute__((address_space(3))) const char* lds_cptr;
typedef short v4i16_t __attribute__((ext_vector_type(4)));
__device__ __forceinline__ void kload8(bf16x8*kf,lds_cptr kp){
  kf[0]=*(const __attribute__((address_space(3))) bf16x8*)(kp);      kf[1]=*(const __attribute__((address_space(3))) bf16x8*)(kp+512);
  kf[2]=*(const __attribute__((address_space(3))) bf16x8*)(kp+2048); kf[3]=*(const __attribute__((address_space(3))) bf16x8*)(kp+2560);
  kf[4]=*(const __attribute__((address_space(3))) bf16x8*)(kp+4096); kf[5]=*(const __attribute__((address_space(3))) bf16x8*)(kp+4608);
  kf[6]=*(const __attribute__((address_space(3))) bf16x8*)(kp+6144); kf[7]=*(const __attribute__((address_space(3))) bf16x8*)(kp+6656);
}
__device__ __forceinline__ void kload2(bf16x8*kf,lds_cptr kp,int j){ kf[2*j]=*(const __attribute__((address_space(3))) bf16x8*)(kp+j*2048); kf[2*j+1]=*(const __attribute__((address_space(3))) bf16x8*)(kp+j*2048+512); }
__device__ __forceinline__ s16x4 vtr(lds_cptr p){ return __builtin_bit_cast(s16x4,__builtin_amdgcn_ds_read_tr16_b64_v4i16((__attribute__((address_space(3))) v4i16_t*)p)); }
__device__ __forceinline__ float rowmax(const f32x16&p0,const f32x16&p1){
  float a=max3f(p0[0],p0[1],p1[0]),b=max3f(p0[2],p0[3],p1[1]);a=max3f(a,p1[2],p1[3]);
  #pragma unroll
  for(int r=4;r<16;r+=4){a=max3f(a,p0[r],p0[r+1]);b=max3f(b,p0[r+2],p0[r+3]);a=max3f(a,p1[r],p1[r+1]);b=max3f(b,p1[r+2],p1[r+3]);}
  const float m=max2f(a,b);
  auto rr=__builtin_amdgcn_permlane32_swap(__float_as_uint(m),__float_as_uint(m),false,false);
  return max2f(__uint_as_float(rr[0]),__uint_as_float(rr[1]));
}
__device__ __forceinline__ void pv(f32x16*o,int vb,bf16x8 pa0,bf16x8 pa1,bf16x8 pa2,bf16x8 pa3){
  #pragma unroll
  for(int d0=0;d0<2;++d0){s16x4 lo[4],hi[4];
    #pragma unroll
    for(int ks=0;ks<4;++ks){
      asm volatile("ds_read_b64_tr_b16 %0,%1 offset:%c2":"=&v"(lo[ks]):"v"(vb),"i"(d0*4096+ks*1024):"memory");
      asm volatile("ds_read_b64_tr_b16 %0,%1 offset:%c2":"=&v"(hi[ks]):"v"(vb),"i"(d0*4096+ks*1024+512):"memory");}
    asm volatile("s_waitcnt lgkmcnt(0)":::"memory");SBAR();
    #define PK(k) (bf16x8){lo[k][0],lo[k][1],lo[k][2],lo[k][3],hi[k][0],hi[k][1],hi[k][2],hi[k][3]}
    o[d0]=__builtin_amdgcn_mfma_f32_32x32x16_bf16(pa0,PK(0),o[d0],0,0,0);
    o[d0]=__builtin_amdgcn_mfma_f32_32x32x16_bf16(pa1,PK(1),o[d0],0,0,0);
    o[d0]=__builtin_amdgcn_mfma_f32_32x32x16_bf16(pa2,PK(2),o[d0],0,0,0);
    o[d0]=__builtin_amdgcn_mfma_f32_32x32x16_bf16(pa3,PK(3),o[d0],0,0,0);
    #undef PK
  }
}

#ifndef ATTN_STORE16
#define ATTN_STORE16(p,v) (*(u32x4*)(p)=(v))
#endif
template<int THRL> __device__ __forceinline__ void attn_unit(int qb,const bf16*Qh,const bf16*__restrict__ Kh,const bf16*__restrict__ Vh,bf16*Oh,char*shm){
  const int tid=threadIdx.x,lane=tid&63,r32=lane&31,hi=lane>>5; const int wid=__builtin_amdgcn_readfirstlane(tid>>6);
  const int q0=qb*QB;
  const bf16*Qw=Qh+(long)(q0+wid*QBLK)*PQ;
  const unsigned lds0=(unsigned)(uintptr_t)shm;
  float*wsf=(float*)(shm+LDS_WS)+wid*64;
  const bf16*ksrc=Kh+(long)lane*PQ+wid*8;
  const bf16*vsrc=Vh+(long)(16*(wid&3)+(lane>>2))*PQ+(wid>>2)*32+(lane&3)*8;
  const unsigned kdst=lds0+LDS_K+wid*1024, vdst=lds0+LDS_V+wid*1024;
  #define DMA_K(t,slot) glds16(ksrc+(long)(t)*KVBLK*PQ,(unsigned)__builtin_amdgcn_readfirstlane(kdst+(slot)))
  #define DMA_V(t,slot) glds16(vsrc+(long)(t)*KVBLK*PQ,(unsigned)__builtin_amdgcn_readfirstlane(vdst+(slot)))
  const int vb0=(int)(lds0+LDS_V)+((lane>>4)&1)*32+(lane&3)*8+(4*hi+((lane&15)>>2))*64;
  const char*Kbase=shm+LDS_K; bf16x8 kf[8];
  const lds_cptr shm3=(lds_cptr)shm; const lds_cptr kp0=shm3+LDS_K+hi*1024+r32*16; const lds_cptr vp0=shm3+LDS_V+((lane>>4)&1)*32+(lane&3)*8+(4*hi+((lane&15)>>2))*64;
  const int NT=(q0+QB)/KVBLK;
  DMA_K(0,0);DMA_V(0,0);DMA_K(1,SLOTB);
  bf16x8 qr[4];
  #pragma unroll
  for(int d0=0;d0<4;++d0)qr[d0]=*reinterpret_cast<const bf16x8*>(&Qw[(long)r32*PQ+d0*16+hi*8]);
  float mhat=0.f,l_reg=0.f;f32x16 o[2];o[0]=f32x16{};o[1]=f32x16{};f32x16 negm=f32x16{};asm volatile("":"+v"(negm));
  const int qrel=wid*QBLK+r32;
  const lds_cfptr tab=(lds_cfptr)((lds_cptr)shm+LDS_TAB);
  #define CMASK(P0,P1,t) do{int jb_=(t)-(NT-4); if(jb_>=-2)cmask(P0,P1,jb_,qrel,hi,tab);}while(0)
  bool resc=false;
  #define START(P0,P1) do{ const float rm=rowmax(P0,P1); resc=false; \
    { const float dl=rm; mhat=fadd_s(mhat,dl); \
      _Pragma("unroll") for(int r=0;r<16;++r){P0[r]=fsub_s(P0[r],dl);P1[r]=fsub_s(P1[r],dl);} \
      _Pragma("unroll") for(int r=0;r<16;++r)negm[r]=-mhat; asm volatile("":"+v"(negm)); } \
    _Pragma("unroll") for(int r=0;r<16;++r)P0[r]=__builtin_amdgcn_exp2f(P0[r]); }while(0)
  #define RESC() do{ if(resc){ asm volatile("s_waitcnt lgkmcnt(0)":::"memory"); \
      _Pragma("unroll") for(int d_=0;d_<2;++d_) _Pragma("unroll") for(int r=0;r<16;++r)o[d_][r]*=wsf[crow(r,hi)]; } }while(0)
  f32x16 pA0,pA1,pB0,pB1;
  int sl_prev=0,sl_cur=0,sl_next=SLOTB;
  #define ROT() do{sl_prev=sl_cur;sl_cur=sl_next;sl_next=(sl_next==(NSLOT-1)*SLOTB)?0:sl_next+SLOTB;}while(0)
  DMA_K(2,2*SLOTB);
  WAIT_BAR(3);
  qkt(pA0,pA1,Kbase,qr,negm,r32,hi);asm volatile("s_nop 15\n\ts_nop 7":"+v"(pA0),"+v"(pA1));CMASK(pA0,pA1,0);
  START(pA0,pA1);
  _Pragma("unroll") for(int r=0;r<16;++r)pA1[r]=__builtin_amdgcn_exp2f(pA1[r]);
  WAIT_BAR(0);
  DMA_K(3,0);DMA_V(1,SLOTB);
  ROT();
  kload8(kf,kp0+sl_cur);
  WAIT_BAR(2);
  s16x4 vlo[8],vhi[8]; u32x4 pw0,pw1,pw2,pw3;
  #define PKW(P,B) cvtpk_s(P[B],P[B+1])
  #define PAF(k) __builtin_bit_cast(bf16x8,pw##k)
  #define VFR(i) (bf16x8){vlo[i][0],vlo[i][1],vlo[i][2],vlo[i][3],vhi[i][0],vhi[i][1],vhi[i][2],vhi[i][3]}
  #define PIN(x) asm volatile("":"+v"(x))
  #define MX3(a,b,c) __builtin_fmaxf(__builtin_fmaxf((a),(b)),(c))
  #define GAPA(MF,A0,A1,A2,A3,W0,W1,PW) do{ MF; sacc+=A0; sacc+=A1; sacc+=A2; sacc+=A3; PIN(sacc); W0; W1; PIN(PW); SBAR(); }while(0)
  #define EX(v) __builtin_amdgcn_exp2f(v)
  #define GAPB(MF,X,B) do{ MF; X[B]=EX(X[B]); X[B+1]=EX(X[B+1]); X[B+2]=EX(X[B+2]); X[B+3]=EX(X[B+3]); PIN(X); SBAR(); }while(0)
  #define VRD(i) do{ vlo[i]=vtr(vp_+(((i)>>2)*4096+((i)&3)*1024)); vhi[i]=vtr(vp_+(((i)>>2)*4096+((i)&3)*1024+512)); }while(0)
  #define KRD(G,j) do{ if(G){ kload2(kf,kp0+sl_next,j); SBAR(); } }while(0)
  #define STEP(C0,C1,P0,P1,t,GK,GV,GL) do{ SBAR(); \
    const lds_cptr vp_=vp0+sl_prev; \
    VRD(0); SBAR(); float sacc=(P0[0]+P0[1]); \
    GAPA(C0=__builtin_amdgcn_mfma_f32_32x32x16_bf16(kf[0],qr[0],negm,0,0,0), P0[2],P0[3],P0[4],P0[5],     pw0[0]=PKW(P0,0), pw0[1]=PKW(P0,2), pw0); \
    VRD(4); SBAR(); GAPA(C1=__builtin_amdgcn_mfma_f32_32x32x16_bf16(kf[1],qr[0],negm,0,0,0), P0[6],P0[7],P0[8],P0[9],     pw0[2]=PKW(P0,4), pw0[3]=PKW(P0,6), pw0); \
    VRD(1); SBAR(); GAPA(C0=__builtin_amdgcn_mfma_f32_32x32x16_bf16(kf[2],qr[1],C0,0,0,0),   P0[10],P0[11],P0[12],P0[13], pw1[0]=PKW(P0,8), pw1[1]=PKW(P0,10), pw1); \
    VRD(5); SBAR(); GAPA(C1=__builtin_amdgcn_mfma_f32_32x32x16_bf16(kf[3],qr[1],C1,0,0,0),   P0[14],P0[15],P1[0],P1[1],   pw1[2]=PKW(P0,12),pw1[3]=PKW(P0,14), pw1); \
    VRD(2); SBAR(); GAPA(C0=__builtin_amdgcn_mfma_f32_32x32x16_bf16(kf[4],qr[2],C0,0,0,0),   P1[2],P1[3],P1[4],P1[5],     pw2[0]=PKW(P1,0), pw2[1]=PKW(P1,2), pw2); \
    VRD(6); SBAR(); GAPA(C1=__builtin_amdgcn_mfma_f32_32x32x16_bf16(kf[5],qr[2],C1,0,0,0),   P1[6],P1[7],P1[8],P1[9],     pw2[2]=PKW(P1,4), pw2[3]=PKW(P1,6), pw2); \
    VRD(3); SBAR(); GAPA(C0=__builtin_amdgcn_mfma_f32_32x32x16_bf16(kf[6],qr[3],C0,0,0,0),   P1[10],P1[11],P1[12],P1[13], pw3[0]=PKW(P1,8), pw3[1]=PKW(P1,10), pw3); \
    VRD(7); SBAR(); GAPA(C1=__builtin_amdgcn_mfma_f32_32x32x16_bf16(kf[7],qr[3],C1,0,0,0),   P1[14],P1[15],0.f,0.f,       pw3[2]=PKW(P1,12),pw3[3]=PKW(P1,14), pw3); \
    l_reg+=sacc; \
    if(GK){DMA_K((t)+3,sl_cur);} if(GV){DMA_V((t)+1,sl_next);} \
    CMASK(C0,C1,t); \
    { float a=MX3(C0[0],C0[1],C1[0]),b=MX3(C0[2],C0[3],C1[1]); a=MX3(a,C1[2],C1[3]); \
      _Pragma("unroll") for(int r=4;r<16;r+=4){a=MX3(a,C0[r],C0[r+1]);b=MX3(b,C0[r+2],C0[r+3]);a=MX3(a,C1[r],C1[r+1]);b=MX3(b,C1[r+2],C1[r+3]);} \
      float rm=__builtin_fmaxf(a,b); { auto rr=__builtin_amdgcn_permlane32_swap(__float_as_uint(rm),__float_as_uint(rm),false,false); rm=__builtin_fmaxf(__uint_as_float(rr[0]),__uint_as_float(rr[1])); } \
      resc=false; \
      if(__builtin_expect(__any(rm>(float)THRL),0)){ const float dl=__builtin_fmaxf(rm,0.f); mhat+=dl; \
        _Pragma("unroll") for(int r=0;r<16;++r){C0[r]-=dl;C1[r]-=dl;} \
        _Pragma("unroll") for(int r=0;r<16;++r)negm[r]=-mhat; asm volatile("":"+v"(negm)); \
        const float f=__builtin_amdgcn_exp2f(-dl); l_reg*=f; if(hi==0)wsf[r32]=f; resc=true; } } \
    SBAR(); \
    GAPB(o[0]=__builtin_amdgcn_mfma_f32_32x32x16_bf16(PAF(0),VFR(0),o[0],0,0,0), C0,0); \
    GAPB(o[1]=__builtin_amdgcn_mfma_f32_32x32x16_bf16(PAF(0),VFR(4),o[1],0,0,0), C0,4); \
    KRD(GL,0); GAPB(o[0]=__builtin_amdgcn_mfma_f32_32x32x16_bf16(PAF(1),VFR(1),o[0],0,0,0), C0,8); \
    KRD(GL,1); GAPB(o[1]=__builtin_amdgcn_mfma_f32_32x32x16_bf16(PAF(1),VFR(5),o[1],0,0,0), C0,12); \
    KRD(GL,2); GAPB(o[0]=__builtin_amdgcn_mfma_f32_32x32x16_bf16(PAF(2),VFR(2),o[0],0,0,0), C1,0); \
    KRD(GL,3); GAPB(o[1]=__builtin_amdgcn_mfma_f32_32x32x16_bf16(PAF(2),VFR(6),o[1],0,0,0), C1,4); \
    GAPB(o[0]=__builtin_amdgcn_mfma_f32_32x32x16_bf16(PAF(3),VFR(3),o[0],0,0,0), C1,8); \
    GAPB(o[1]=__builtin_amdgcn_mfma_f32_32x32x16_bf16(PAF(3),VFR(7),o[1],0,0,0), C1,12); \
    }while(0)
  int t=1;
  #undef CMASK
  #define CMASK(P0,P1,t) do{}while(0)
  for(;t+7<NT;t+=2){
    STEP(pB0,pB1,pA0,pA1,t,true,true,true);     WAIT_BAR(2); RESC(); ROT();
    STEP(pA0,pA1,pB0,pB1,t+1,true,true,true);   WAIT_BAR(2); RESC(); ROT();
  }
  #undef CMASK
  #define CMASK(P0,P1,t) do{int jb_=(t)-(NT-4); if(jb_>=-2)cmask(P0,P1,jb_,qrel,hi,tab);}while(0)
  #define ENDW(tt) do{ if((tt)+3<NT){WAIT_BAR(2);} else if((tt)+2<NT){WAIT_BAR(1);} else {WAIT_BAR(0);} }while(0)
  for(;t+1<NT;t+=2){
    STEP(pB0,pB1,pA0,pA1,t,(t+3<NT),(t+1<NT),(t+1<NT));       ENDW(t);   RESC(); ROT();
    STEP(pA0,pA1,pB0,pB1,t+1,(t+4<NT),(t+2<NT),(t+2<NT));     ENDW(t+1); RESC(); ROT();
  }
  STEP(pB0,pB1,pA0,pA1,NT-1,false,false,false); RESC();
  { float sacc=pB0[0]+pB0[1]; _Pragma("unroll") for(int r=2;r<16;++r)sacc+=pB0[r]; _Pragma("unroll") for(int r=0;r<16;++r)sacc+=pB1[r]; l_reg+=sacc;
    pw0=(u32x4){PKW(pB0,0),PKW(pB0,2),PKW(pB0,4),PKW(pB0,6)};pw1=(u32x4){PKW(pB0,8),PKW(pB0,10),PKW(pB0,12),PKW(pB0,14)};pw2=(u32x4){PKW(pB1,0),PKW(pB1,2),PKW(pB1,4),PKW(pB1,6)};pw3=(u32x4){PKW(pB1,8),PKW(pB1,10),PKW(pB1,12),PKW(pB1,14)};
    SBAR(); pv(o,vb0+sl_cur,PAF(0),PAF(1),PAF(2),PAF(3)); }
  #undef PKW
  #undef PAF
  #undef VFR
  #undef PIN
  #undef MX3
  #undef GAPA
  #undef GAPB
  #undef EX
  #undef VRD
  #undef KRD
  #undef STEP
  #undef ENDW
  {auto rr=__builtin_amdgcn_permlane32_swap(__float_as_uint(l_reg),__float_as_uint(l_reg),false,false);l_reg=__uint_as_float(rr[0])+__uint_as_float(rr[1]);}
  if(hi==0)wsf[32+r32]=l_reg;asm volatile("s_waitcnt lgkmcnt(0)":::"memory");
  float rli[16];
  #pragma unroll
  for(int r=0;r<16;++r)rli[r]=__builtin_amdgcn_rcpf(wsf[32+crow(r,hi)]);
  bf16*Ow=Oh+(long)(q0+wid*QBLK)*PO;
  { bf16*stg=(bf16*)(shm+LDS_OST)+wid*2048;
    #pragma unroll
    for(int r=0;r<16;++r){const int orow=crow(r,hi);
      #pragma unroll
      for(int d0=0;d0<2;++d0)stg[orow*64+d0*32+r32]=__float2bfloat16(o[d0][r]*rli[r]);}
    asm volatile("s_waitcnt lgkmcnt(0)":::"memory");
    #pragma unroll
    for(int i=0;i<4;++i){const int row=i*8+(lane>>3),ch=lane&7; const u32x4 v=*(const u32x4*)(stg+row*64+ch*8); ATTN_STORE16(Ow+(long)row*PO+ch*8,v);} }
  asm volatile("s_waitcnt lgkmcnt(0)\n\ts_barrier":::"memory");
  #undef DMA_K
  #undef DMA_V
  #undef CMASK
  #undef START
  #undef RESC
  #undef ROT
}
constexpr int ATTN_LDS_BYTES=LDS_BYTES;
constexpr int SLOTV=2*SLOTB;
constexpr int LDS2_K=0, LDS2_V=NSLOT*SLOTB, LDS2_WS=LDS2_V+NSLOT*SLOTV, LDS2_OST=LDS2_WS+NW*64*4, LDS2_TAB=LDS2_OST+NW*4096, LDS2_BYTES=LDS2_TAB+512;
template<int THRL> __device__ __forceinline__ void attn_unit2(int qb,const bf16*Qh,const bf16*__restrict__ Kh,const bf16*__restrict__ Vh,bf16*Oh,char*shm){
  int tid_=threadIdx.x; asm volatile("":"+v"(tid_));
  const int tid=tid_,lane=tid&63,r32=lane&31,hi=lane>>5; const int wid=__builtin_amdgcn_readfirstlane(tid>>6);
  const int q0=qb*QB;
  const bf16*Qw=Qh+(long)(q0+wid*QBLK)*PQ;
  const unsigned lds0=(unsigned)(uintptr_t)shm;
  float*wsf=(float*)(shm+LDS2_WS)+wid*64;
  const bf16*ksrc=Kh+(long)lane*PQ+wid*8;
  const bf16*vsrc=Vh+(long)(16*(wid&3)+(lane>>2))*PQ+(wid>>2)*32+(lane&3)*8;
  const unsigned kdst=lds0+LDS2_K+wid*1024, vdst=lds0+LDS2_V+wid*1024;
  #define DMA_K(t,slot) glds16(ksrc+(long)(t)*KVBLK*PQ,(unsigned)__builtin_amdgcn_readfirstlane(kdst+(slot)))
  #define DMA_V(t,slot) do{ glds16(vsrc+(long)(t)*KVBLK*PQ,(unsigned)__builtin_amdgcn_readfirstlane(vdst+2*(slot))); glds16(vsrc+(long)(t)*KVBLK*PQ+64,(unsigned)__builtin_amdgcn_readfirstlane(vdst+2*(slot)+SLOTB)); }while(0)
  const int vb0=(int)(lds0+LDS2_V)+((lane>>4)&1)*32+(lane&3)*8+(4*hi+((lane&15)>>2))*64;
  const char*Kbase=shm+LDS2_K; bf16x8 kf[8];
  const lds_cptr shm3=(lds_cptr)shm; const lds_cptr kp0=shm3+LDS2_K+hi*1024+r32*16; const lds_cptr vp0=shm3+LDS2_V+((lane>>4)&1)*32+(lane&3)*8+(4*hi+((lane&15)>>2))*64;
  const int NT=(q0+QB)/KVBLK;
  DMA_K(0,0);DMA_V(0,0);DMA_K(1,SLOTB);
  bf16x8 qr[4];
  #pragma unroll
  for(int d0=0;d0<4;++d0)qr[d0]=*reinterpret_cast<const bf16x8*>(&Qw[(long)r32*PQ+d0*16+hi*8]);
  float mhat=0.f,l_reg=0.f;f32x16 o[4];o[0]=f32x16{};o[1]=f32x16{};o[2]=f32x16{};o[3]=f32x16{};
  const f32x16 zero16=f32x16{};
  const int qrel=wid*QBLK+r32;
  const lds_cfptr tab=(lds_cfptr)((lds_cptr)shm+LDS2_TAB);
  #define CMASK(P0,P1,t) do{int jb_=(t)-(NT-4); if(jb_>=-2)cmask(P0,P1,jb_,qrel,hi,tab);}while(0)
  bool resc=false;
  #define RESC() do{ if(resc){ asm volatile("s_waitcnt lgkmcnt(0)":::"memory"); \
      _Pragma("unroll") for(int d_=0;d_<4;++d_) _Pragma("unroll") for(int r=0;r<16;++r)o[d_][r]*=wsf[crow(r,hi)]; } }while(0)
  f32x16 c0,c1; u32x4 pa0,pa1,pa2,pa3,pb0,pb1,pb2,pb3;
  int sl_prev=0,sl_cur=0,sl_next=SLOTB;
  #define ROT() do{sl_prev=sl_cur;sl_cur=sl_next;sl_next=(sl_next==(NSLOT-1)*SLOTB)?0:sl_next+SLOTB;}while(0)
  #define PKW(P,B) cvtpk_s(P[B],P[B+1])
  #define EX(v) __builtin_amdgcn_exp2f(v)
  DMA_K(2,2*SLOTB);
  WAIT_BAR(4);
  qkt(c0,c1,Kbase,qr,zero16,r32,hi);asm volatile("s_nop 15\n\ts_nop 7":"+v"(c0),"+v"(c1));CMASK(c0,c1,0);
  { mhat=rowmax(c0,c1);
    _Pragma("unroll") for(int r=0;r<16;++r){c0[r]=EX(c0[r]-mhat);c1[r]=EX(c1[r]-mhat);}
    float sacc=c0[0]+c0[1]; _Pragma("unroll") for(int r=2;r<16;++r)sacc+=c0[r]; _Pragma("unroll") for(int r=0;r<16;++r)sacc+=c1[r]; l_reg=sacc;
    pa0=(u32x4){PKW(c0,0),PKW(c0,2),PKW(c0,4),PKW(c0,6)};pa1=(u32x4){PKW(c0,8),PKW(c0,10),PKW(c0,12),PKW(c0,14)};pa2=(u32x4){PKW(c1,0),PKW(c1,2),PKW(c1,4),PKW(c1,6)};pa3=(u32x4){PKW(c1,8),PKW(c1,10),PKW(c1,12),PKW(c1,14)}; }
  WAIT_BAR(0);
  DMA_K(3,0);DMA_V(1,SLOTB);
  ROT();
  kload8(kf,kp0+sl_cur);
  WAIT_BAR(3);
  s16x4 vlo[8],vhi[8];
  #define PAFX(X,k) __builtin_bit_cast(bf16x8,X##k)
  #define VFR(i) (bf16x8){vlo[i][0],vlo[i][1],vlo[i][2],vlo[i][3],vhi[i][0],vhi[i][1],vhi[i][2],vhi[i][3]}
  #define PIN(x) asm volatile("":"+v"(x))
  #define MX3(a,b,c) __builtin_fmaxf(__builtin_fmaxf((a),(b)),(c))
  #define VRD(i) do{ vlo[i]=vtr(vp_+(((i)>>2)*4096+((i)&3)*1024)); vhi[i]=vtr(vp_+(((i)>>2)*4096+((i)&3)*1024+512)); }while(0)
  #define VRD1(i) do{ vlo[i]=vtr(vp_+(SLOTB+((i)>>2)*4096+((i)&3)*1024)); vhi[i]=vtr(vp_+(SLOTB+((i)>>2)*4096+((i)&3)*1024+512)); }while(0)
  #define KRD(G,j) do{ if(G){ kload2(kf,kp0+sl_next,j); SBAR(); } }while(0)
  #define QKG(MF) do{ MF; SBAR(); }while(0)
  #define GAPB(MF,RD,Xc,B) do{ MF; RD; Xc[B]=EX(Xc[B]-mhat); Xc[B+1]=EX(Xc[B+1]-mhat); Xc[B+2]=EX(Xc[B+2]-mhat); Xc[B+3]=EX(Xc[B+3]-mhat); PIN(Xc); SBAR(); }while(0)
  #define GAPC(MF,A0,A1,A2,A3,W0,W1,PW) do{ MF; sacc+=A0; sacc+=A1; sacc+=A2; sacc+=A3; PIN(sacc); W0; W1; PIN(PW); SBAR(); }while(0)
  #define MF32(a,b,c) __builtin_amdgcn_mfma_f32_32x32x16_bf16(a,b,c,0,0,0)
  #define STEP2(X,Y,t,GK,GV,GL) do{ SBAR(); \
    const lds_cptr vp_=vp0+2*sl_prev; \
    VRD(0); SBAR(); QKG(c0=MF32(kf[0],qr[0],zero16)); \
    VRD(4); SBAR(); QKG(c1=MF32(kf[1],qr[0],zero16)); \
    VRD(1); SBAR(); QKG(c0=MF32(kf[2],qr[1],c0)); \
    VRD(5); SBAR(); QKG(c1=MF32(kf[3],qr[1],c1)); \
    VRD(2); SBAR(); QKG(c0=MF32(kf[4],qr[2],c0)); \
    VRD(6); SBAR(); QKG(c1=MF32(kf[5],qr[2],c1)); \
    VRD(3); SBAR(); QKG(c0=MF32(kf[6],qr[3],c0)); \
    VRD(7); SBAR(); QKG(c1=MF32(kf[7],qr[3],c1)); \
    if(GK){DMA_K((t)+3,sl_cur);} if(GV){DMA_V((t)+1,sl_next);} \
    CMASK(c0,c1,t); \
    { float a=MX3(c0[0],c0[1],c1[0]),b=MX3(c0[2],c0[3],c1[1]); a=MX3(a,c1[2],c1[3]); \
      _Pragma("unroll") for(int r=4;r<16;r+=4){a=MX3(a,c0[r],c0[r+1]);b=MX3(b,c0[r+2],c0[r+3]);a=MX3(a,c1[r],c1[r+1]);b=MX3(b,c1[r+2],c1[r+3]);} \
      float rm=__builtin_fmaxf(a,b); { auto rr=__builtin_amdgcn_permlane32_swap(__float_as_uint(rm),__float_as_uint(rm),false,false); rm=__builtin_fmaxf(__uint_as_float(rr[0]),__uint_as_float(rr[1])); } \
      rm-=mhat; resc=false; \
      if(__builtin_expect(__any(rm>(float)THRL),0)){ const float dl=__builtin_fmaxf(rm,0.f); mhat+=dl; \
        const float f=__builtin_amdgcn_exp2f(-dl); l_reg*=f; if(hi==0)wsf[r32]=f; resc=true; } } \
    SBAR(); \
    GAPB(o[0]=MF32(PAFX(X,0),VFR(0),o[0]), VRD1(0), c0,0); \
    GAPB(o[1]=MF32(PAFX(X,0),VFR(4),o[1]), VRD1(4), c0,4); \
    KRD(GL,0); GAPB(o[0]=MF32(PAFX(X,1),VFR(1),o[0]), VRD1(1), c0,8); \
    KRD(GL,1); GAPB(o[1]=MF32(PAFX(X,1),VFR(5),o[1]), VRD1(5), c0,12); \
    KRD(GL,2); GAPB(o[0]=MF32(PAFX(X,2),VFR(2),o[0]), VRD1(2), c1,0); \
    KRD(GL,3); GAPB(o[1]=MF32(PAFX(X,2),VFR(6),o[1]), VRD1(6), c1,4); \
    GAPB(o[0]=MF32(PAFX(X,3),VFR(3),o[0]), VRD1(3), c1,8); \
    GAPB(o[1]=MF32(PAFX(X,3),VFR(7),o[1]), VRD1(7), c1,12); \
    float sacc=(c0[0]+c0[1]); \
    GAPC(o[2]=MF32(PAFX(X,0),VFR(0),o[2]), c0[2],c0[3],c0[4],c0[5],     Y##0[0]=PKW(c0,0), Y##0[1]=PKW(c0,2), Y##0); \
    GAPC(o[3]=MF32(PAFX(X,0),VFR(4),o[3]), c0[6],c0[7],c0[8],c0[9],     Y##0[2]=PKW(c0,4), Y##0[3]=PKW(c0,6), Y##0); \
    GAPC(o[2]=MF32(PAFX(X,1),VFR(1),o[2]), c0[10],c0[11],c0[12],c0[13], Y##1[0]=PKW(c0,8), Y##1[1]=PKW(c0,10), Y##1); \
    GAPC(o[3]=MF32(PAFX(X,1),VFR(5),o[3]), c0[14],c0[15],c1[0],c1[1],   Y##1[2]=PKW(c0,12),Y##1[3]=PKW(c0,14), Y##1); \
    GAPC(o[2]=MF32(PAFX(X,2),VFR(2),o[2]), c1[2],c1[3],c1[4],c1[5],     Y##2[0]=PKW(c1,0), Y##2[1]=PKW(c1,2), Y##2); \
    GAPC(o[3]=MF32(PAFX(X,2),VFR(6),o[3]), c1[6],c1[7],c1[8],c1[9],     Y##2[2]=PKW(c1,4), Y##2[3]=PKW(c1,6), Y##2); \
    GAPC(o[2]=MF32(PAFX(X,3),VFR(3),o[2]), c1[10],c1[11],c1[12],c1[13], Y##3[0]=PKW(c1,8), Y##3[1]=PKW(c1,10), Y##3); \
    GAPC(o[3]=MF32(PAFX(X,3),VFR(7),o[3]), c1[14],c1[15],0.f,0.f,       Y##3[2]=PKW(c1,12),Y##3[3]=PKW(c1,14), Y##3); \
    l_reg+=sacc; \
    }while(0)
  int t=1;
  #undef CMASK
  #define CMASK(P0,P1,t) do{}while(0)
  for(;t+7<NT;t+=2){
    STEP2(pa,pb,t,true,true,true);     WAIT_BAR(3); RESC(); ROT();
    STEP2(pb,pa,t+1,true,true,true);   WAIT_BAR(3); RESC(); ROT();
  }
  #undef CMASK
  #define CMASK(P0,P1,t) do{int jb_=(t)-(NT-4); if(jb_>=-2)cmask(P0,P1,jb_,qrel,hi,tab);}while(0)
  #define ENDW(tt) do{ if((tt)+3<NT){WAIT_BAR(3);} else if((tt)+2<NT){WAIT_BAR(2);} else {WAIT_BAR(0);} }while(0)
  for(;t+1<NT;t+=2){
    STEP2(pa,pb,t,(t+3<NT),(t+1<NT),(t+1<NT));       ENDW(t);   RESC(); ROT();
    STEP2(pb,pa,t+1,(t+4<NT),(t+2<NT),(t+2<NT));     ENDW(t+1); RESC(); ROT();
  }
  STEP2(pa,pb,NT-1,false,false,false); RESC();
  { SBAR(); pv(o,vb0+2*sl_cur,PAFX(pb,0),PAFX(pb,1),PAFX(pb,2),PAFX(pb,3)); pv(o+2,vb0+2*sl_cur+SLOTB,PAFX(pb,0),PAFX(pb,1),PAFX(pb,2),PAFX(pb,3)); }
  #undef PKW
  #undef PAFX
  #undef VFR
  #undef PIN
  #undef MX3
  #undef GAPB
  #undef GAPC
  #undef QKG
  #undef MF32
  #undef EX
  #undef VRD
  #undef VRD1
  #undef KRD
  #undef STEP2
  #undef ENDW
  {auto rr=__builtin_amdgcn_permlane32_swap(__float_as_uint(l_reg),__float_as_uint(l_reg),false,false);l_reg=__uint_as_float(rr[0])+__uint_as_float(rr[1]);}
  if(hi==0)wsf[32+r32]=l_reg;asm volatile("s_waitcnt lgkmcnt(0)":::"memory");
  float rli[16];
  #pragma unroll
  for(int r=0;r<16;++r)rli[r]=__builtin_amdgcn_rcpf(wsf[32+crow(r,hi)]);
  bf16*Ow=Oh+(long)(q0+wid*QBLK)*PO;
  #pragma unroll
  for(int hv=0;hv<2;++hv){ bf16*stg=(bf16*)(shm+LDS2_OST)+wid*2048;
    #pragma unroll
    for(int r=0;r<16;++r){const int orow=crow(r,hi);
      #pragma unroll
      for(int d0=0;d0<2;++d0)stg[orow*64+d0*32+r32]=__float2bfloat16(o[2*hv+d0][r]*rli[r]);}
    asm volatile("s_waitcnt lgkmcnt(0)":::"memory");
    #pragma unroll
    for(int i=0;i<4;++i){const int row=i*8+(lane>>3),ch=lane&7; const u32x4 v=*(const u32x4*)(stg+row*64+ch*8); ATTN_STORE16(Ow+(long)row*PO+hv*64+ch*8,v);}
    asm volatile("s_waitcnt lgkmcnt(0)":::"memory"); }
  asm volatile("s_waitcnt lgkmcnt(0)\n\ts_barrier":::"memory");
  #undef DMA_K
  #undef DMA_V
  #undef CMASK
  #undef RESC
  #undef ROT
}
#undef SBAR
#undef WAIT_BAR
}

constexpr int NWAVES = 8;
#ifndef MK_PER_PHASE
#define MK_PER_PHASE 0
#endif
constexpr int NPHASE = 20;

constexpr int BATCH = 2, SEQ = 4096, T = BATCH * SEQ, D = 2048;
constexpr int NAB = 6144, NABX = 6160;
constexpr int C_QA = 0, C_KA = 1024, C_VA = 2048, C_QB = 3072, C_KB = 3584, C_VB = 4096, C_RB = 5120;
constexpr int NEXP = 32, FF = 512, CAPROWS = 24576;
constexpr float EPS = 1e-6f;
constexpr float LOG2E = 1.4426950408889634f;

constexpr size_t MiB = 1u << 20;
constexpr size_t WS_CTL = 0, CTL_ZERO_BYTES = 65536;
constexpr size_t WS_WAB = 1 * MiB;
constexpr size_t WS_WOAB = 26 * MiB;
constexpr size_t WS_WINC = 34 * MiB;
constexpr size_t WS_WOC = 50 * MiB;
constexpr size_t WS_WR = 58 * MiB;
constexpr size_t WS_BIAS = 59 * MiB;
constexpr size_t WS_WGU = 60 * MiB;
constexpr size_t WS_WDN = 316 * MiB;
constexpr size_t WS_X = 444 * MiB;
constexpr size_t WS_H = 508 * MiB;
constexpr size_t WS_PROJ = 540 * MiB;
constexpr size_t WS_ORAW = 636 * MiB;
constexpr size_t WS_CAT = 668 * MiB;
constexpr size_t WS_GQ = 700 * MiB, WS_GK = 708 * MiB;
constexpr size_t WS_GB = 716 * MiB;
constexpr size_t WS_STATS = 700 * MiB;
constexpr size_t WS_DEC = 717 * MiB;
constexpr size_t WS_DS = 718 * MiB;
constexpr size_t WS_ST = 782 * MiB;
constexpr size_t WS_ACT = 814 * MiB;
constexpr size_t WS_LIST = 838 * MiB;
constexpr size_t WS_TOK = 839 * MiB;
constexpr size_t WS_END = 840 * MiB;
constexpr int CW_BAR = 4096;
constexpr int CW_MOEUP = 14336, MOEUP_STRIDE = 8;
static_assert((CW_MOEUP + 2 * 96 * MOEUP_STRIDE) * 4 <= 65536 && CW_MOEUP >= 12288 + 1024, "MoE counters inside the memset region");
constexpr int CW_QGEMM = 12288, CW_QCONV = 12288 + 512;
constexpr int NXCD_ = 8;
constexpr int CW_CNT = 8192;
static_assert((CW_QCONV + 8 * 64) * 4 <= (int)CTL_ZERO_BYTES && CW_CNT + 2 * 2048 <= CW_QGEMM, "queue words inside the memset region");
static_assert((CW_CNT + 2 * 2048) * 4 <= (int)CTL_ZERO_BYTES, "CTL words inside the memset region");

constexpr int RING_OFF = 0, RING_BYTES = 131072;
constexpr int SCR_BYTES = 143360;
constexpr int LDSCTL_OFF = SCR_BYTES;
constexpr int MISC_OFF = LDSCTL_OFF;
constexpr int MOE_OFF = LDSCTL_OFF + 256;
constexpr int LDS_BYTES = 147456;

#define GAS __attribute__((address_space(1)))
#define LAS __attribute__((address_space(3)))
typedef unsigned short bf16;
typedef unsigned v4u __attribute__((ext_vector_type(4)));
typedef unsigned v2u __attribute__((ext_vector_type(2)));
typedef float f32x4 __attribute__((ext_vector_type(4)));
typedef short bf16x8 __attribute__((ext_vector_type(8)));
typedef GAS unsigned gu32;
#define RLX_AGENT __ATOMIC_RELAXED, __HIP_MEMORY_SCOPE_AGENT
#define LDS_WAIT() asm volatile("s_waitcnt lgkmcnt(0)" ::: "memory")
#define VM_WAIT() asm volatile("s_waitcnt vmcnt(0)" ::: "memory")
__device__ __forceinline__ unsigned f2bf(float f) { unsigned u = __builtin_bit_cast(unsigned, f); return (u + 0x7fffu + ((u >> 16) & 1u)) >> 16; }
__device__ __forceinline__ unsigned pk2(float lo, float hi) { return f2bf(lo) | (f2bf(hi) << 16); }
__device__ __forceinline__ float bf2f(unsigned short b) { return __builtin_bit_cast(float, (unsigned)b << 16); }
__device__ __forceinline__ float bflo(unsigned w) { return __builtin_bit_cast(float, w << 16); }
__device__ __forceinline__ float bfhi(unsigned w) { return __builtin_bit_cast(float, w & 0xffff0000u); }

#define XB_TMO      128
#define XB_XCNT(j)  (256  + 64 * (j))
#define XB_XSUB(j)  (1280 + 64 * (j))
#define XB_XGEN(j)  (2304 + 64 * (j))
#define XB_TOP      3328
#define XB_TOPGEN   3392
#define XCD_BAR_WORDS 3456
#define XB_SPIN_CAP (1u << 18)

__device__ __forceinline__ unsigned xb_ld(unsigned* p)              { return __hip_atomic_load(p, __ATOMIC_RELAXED, __HIP_MEMORY_SCOPE_AGENT); }
__device__ __forceinline__ unsigned xb_add(unsigned* p, unsigned v) { return __hip_atomic_fetch_add(p, v, __ATOMIC_RELAXED, __HIP_MEMORY_SCOPE_AGENT); }
__device__ __forceinline__ unsigned xb_xcc_id() { return (unsigned)__builtin_amdgcn_s_getreg((3 << 11) | 20) & 0xFu; }
#define XB_SPIN(cond, bar) do { unsigned _sp = 0; while (cond) { __builtin_amdgcn_s_sleep(1); \
    if ((++_sp & 255u) == 0u) { if (xb_ld(&(bar)[XB_TMO])) break; if (_sp > XB_SPIN_CAP) { atomicAdd(&(bar)[XB_TMO], 1u); break; } } } } while (0)

struct XcdBarrier {
    unsigned* bar; unsigned x;
    volatile LAS unsigned* st;
};
__device__ __forceinline__ XcdBarrier xcd_barrier_post(unsigned* bar, volatile LAS unsigned* st) {
    XcdBarrier b; b.bar = bar; b.x = xb_xcc_id(); b.st = st;
    if (threadIdx.x == 0) (void)xb_add(&bar[XB_XCNT(b.x)], 1u);
    return b;
}
__device__ __forceinline__ void xcd_barrier_complete(unsigned* bar, unsigned x, unsigned& nloc, unsigned& nx) {
    const unsigned G = gridDim.x * gridDim.y * gridDim.z;
    unsigned sum, cnt, mine, sp = 0u;
    for (;;) {
        sum = 0u; cnt = 0u; mine = 0u;
#pragma unroll
        for (unsigned j = 0; j < 16; ++j) { const unsigned c = xb_ld(&bar[XB_XCNT(j)]); sum += c; cnt += (c > 0u) ? 1u : 0u; mine = (j == x) ? c : mine; }
        if (sum == G) break;
        __builtin_amdgcn_s_sleep(1);
        if ((++sp & 255u) == 0u) { if (xb_ld(&bar[XB_TMO])) break; if (sp > XB_SPIN_CAP) { atomicAdd(&bar[XB_TMO], 1u); break; } }
    }
    nloc = mine > 0u ? mine : 1u; nx = cnt > 0u ? cnt : 1u;
}
__device__ __forceinline__ void xcd_barrier(const XcdBarrier& b) {
    asm volatile("s_waitcnt vmcnt(0)" ::: "memory");
    __syncthreads();
    if (threadIdx.x == 0) {
        unsigned* bar = b.bar;
        __builtin_amdgcn_s_waitcnt(0);
        unsigned nloc = b.st[0], nx = b.st[1];
        if (nloc == 0u) { xcd_barrier_complete(bar, b.x, nloc, nx); b.st[0] = nloc; b.st[1] = nx; }
        const unsigned old = xb_add(&bar[XB_XSUB(b.x)], 1u);
        const unsigned gen = old / nloc;
        if (old + 1u == (gen + 1u) * nloc) {
            __builtin_amdgcn_fence(__ATOMIC_RELEASE, "agent");
            asm volatile("s_waitcnt vmcnt(0)" ::: "memory");
            const unsigned og = xb_add(&bar[XB_TOP], 1u);
            const unsigned tg = og / nx;
            if (og + 1u == (tg + 1u) * nx) xb_add(&bar[XB_TOPGEN], 1u);
            else XB_SPIN(xb_ld(&bar[XB_TOPGEN]) == tg, bar);
            __builtin_amdgcn_fence(__ATOMIC_ACQUIRE, "agent");
            xb_add(&bar[XB_XGEN(b.x)], 1u);
            asm volatile("s_waitcnt vmcnt(0)" ::: "memory");
        } else {
            XB_SPIN(xb_ld(&bar[XB_XGEN(b.x)]) == gen, bar);
            __builtin_amdgcn_fence(__ATOMIC_ACQUIRE, "agent");
            asm volatile("s_waitcnt vmcnt(0)" ::: "memory");
        }
    }
    __syncthreads();
}

struct Frame {
    LAS unsigned char* lds;
    gu32* ctl;
    unsigned char* ws;
    int tid, lane, wave;
    int vcu, G;
};
__device__ __forceinline__ float wave_sum(float v) {
#pragma unroll
    for (int o = 1; o < 64; o <<= 1) v += __shfl_xor(v, o);
    return v;
}
#define WG_SYNC() do { asm volatile("s_waitcnt vmcnt(0) lgkmcnt(0)" ::: "memory"); __builtin_amdgcn_s_barrier(); asm volatile("" ::: "memory"); } while (0)

struct XItem { const float* W; bf16* dst; int ldw, ldd, k0, n0; };
__device__ __forceinline__ unsigned cvtpk_hw(float lo, float hi) { typedef float f2_t __attribute__((ext_vector_type(2))); typedef __bf16 b2_t __attribute__((ext_vector_type(2))); f2_t v = {lo, hi}; b2_t r = __builtin_convertvector(v, b2_t); return __builtin_bit_cast(unsigned, r); }
__device__ __forceinline__ void xpose_load(const XItem& x, f32x4 (&xs)[8], int lane) {
    const char* base = (const char*)(x.W + (size_t)x.k0 * x.ldw + x.n0);
    const unsigned loff = ((unsigned)(lane >> 3) * 8u * (unsigned)x.ldw + 4u * (unsigned)(lane & 7)) * 4u;
    const size_t rstep = (size_t)x.ldw * 4;
#pragma unroll
    for (int i = 0; i < 8; ++i) xs[i] = __builtin_nontemporal_load((const f32x4*)(base + i * rstep + loff));
}
__device__ __forceinline__ void xpose_finish(const XItem& x, const f32x4 (&xs)[8], LAS float*, int lane) {
    const int src4 = 4 * ((lane >> 3) + 8 * (lane & 7));
    char* dbase = (char*)(x.dst + x.k0);
    const unsigned doff = ((unsigned)(4 * (lane >> 3)) * (unsigned)x.ldd + 8u * (unsigned)(lane & 7)) * 2u;
    const size_t dstep = (size_t)x.ldd * 2;
#define XP_ONE(E, M) { v4u o; o.x = (unsigned)__builtin_amdgcn_ds_bpermute(src4, (int)cvtpk_hw(xs[0].M, xs[1].M)); o.y = (unsigned)__builtin_amdgcn_ds_bpermute(src4, (int)cvtpk_hw(xs[2].M, xs[3].M)); \
        o.z = (unsigned)__builtin_amdgcn_ds_bpermute(src4, (int)cvtpk_hw(xs[4].M, xs[5].M)); o.w = (unsigned)__builtin_amdgcn_ds_bpermute(src4, (int)cvtpk_hw(xs[6].M, xs[7].M)); \
        __builtin_nontemporal_store(o, (v4u*)(dbase + (E) * dstep + doff)); }
    XP_ONE(0, x) XP_ONE(1, y) XP_ONE(2, z) XP_ONE(3, w)
#undef XP_ONE
}
__device__ const unsigned char T5_BUCKET[128] = {
    0, 1, 2, 3, 4, 5, 6, 7, 8, 9, 10, 11, 12, 13, 14, 15, 16, 16, 16, 17, 17, 18, 18, 18, 19, 19, 19, 20, 20, 20, 20, 21, 21, 21, 21, 22, 22, 22, 22, 22, 23, 23, 23, 23, 23, 23, 24, 24, 24, 24, 24, 24,
    25, 25, 25, 25, 25, 25, 25, 26, 26, 26, 26, 26, 26, 26, 26, 27, 27, 27, 27, 27, 27, 27, 27, 27, 27, 28, 28, 28, 28, 28, 28, 28, 28, 28, 28, 29, 29, 29, 29, 29, 29, 29, 29, 29, 29, 29, 29,
    30, 30, 30, 30, 30, 30, 30, 30, 30, 30, 30, 30, 30, 30, 31, 31, 31, 31, 31, 31, 31, 31, 31, 31, 31, 31, 31, 31, 31};

struct P0Args { const float *w_in_ab, *w_out_ab, *w_in_c, *w_out_c, *w_gate, *w_up, *w_down, *rel_bias; };
constexpr int P0_I_AB = 32 * 192, P0_I_SQ = 32 * 64, P0_I_C = 32 * 128, P0_I_E = 512 * 64;
constexpr int P0_NITEMS = P0_I_AB + P0_I_SQ + P0_I_C + P0_I_SQ + 3 * P0_I_E;
constexpr int P0_TICK = 8;
constexpr int P0_NTICK_XCD = (P0_NITEMS - P0_I_AB) / P0_TICK / NXCD_;
static_assert((P0_NITEMS - P0_I_AB) % (P0_TICK * NXCD_) == 0, "ticket split");
__device__ __forceinline__ XItem p0_decode(const P0Args& a, unsigned char* ws, int it) {
    constexpr int I_AB = P0_I_AB, I_SQ = P0_I_SQ, I_C = P0_I_C, I_E = P0_I_E;
    bf16* WAB = (bf16*)(ws + WS_WAB); bf16* WOAB = (bf16*)(ws + WS_WOAB); bf16* WINC = (bf16*)(ws + WS_WINC); bf16* WOC = (bf16*)(ws + WS_WOC);
    bf16* WGU = (bf16*)(ws + WS_WGU); bf16* WDN = (bf16*)(ws + WS_WDN);
    int r = it;
    if (r < I_AB) { const int kb = r / 192, nb = r % 192; return XItem{a.w_in_ab, WAB + (size_t)(32 * nb) * D, NABX, D, 64 * kb, 32 * nb}; } r -= I_AB;
    if (r < I_SQ) { const int kb = r / 64, nb = r % 64; return XItem{a.w_out_ab, WOAB + (size_t)(32 * nb) * D, D, D, 64 * kb, 32 * nb}; } r -= I_SQ;
    if (r < I_C) { const int kb = r / 128, nb = r % 128; return XItem{a.w_in_c, WINC + (size_t)(32 * nb) * D, 2 * D, D, 64 * kb, 32 * nb}; } r -= I_C;
    if (r < I_SQ) { const int kb = r / 64, nb = r % 64; return XItem{a.w_out_c, WOC + (size_t)(32 * nb) * D, D, D, 64 * kb, 32 * nb}; } r -= I_SQ;
    if (r < 2 * I_E) {
        const int up = r >= I_E; if (up) r -= I_E;
        const int le = r >> 9, q = r & 511, kb = q >> 4, nb = q & 15, n0 = 32 * nb, row = 256 * (n0 >> 7) + (n0 & 127) + 128 * up;
        return XItem{(up ? a.w_up : a.w_gate) + (size_t)le * D * FF, WGU + ((size_t)le * 1024 + row) * D, FF, D, 64 * kb, n0}; }
    r -= 2 * I_E;
    const int le = r >> 9, q = r & 511, kb = q >> 6, nb = q & 63;
    return XItem{a.w_down + (size_t)le * FF * D, WDN + ((size_t)le * D + 32 * nb) * FF, D, FF, 64 * kb, 32 * nb};
}
__device__ __forceinline__ void p0_convert(Frame& F, const P0Args& a, int nitems) {
    LAS float* scr = (LAS float*)(F.lds + RING_OFF + F.wave * 16384);
    const int gw = F.vcu * NWAVES + F.wave, NGW = F.G * NWAVES;
    if (gw < nitems) {
        XItem cur = p0_decode(a, F.ws, gw); f32x4 xa[8], xb[8]; xpose_load(cur, xa, F.lane);
        int it = gw;
        for (; it + NGW < nitems; it += NGW) {
            const XItem nxt = p0_decode(a, F.ws, it + NGW); xpose_load(nxt, xb, F.lane);
            xpose_finish(cur, xa, scr, F.lane);
            cur = nxt;
#pragma unroll
            for (int i = 0; i < 8; ++i) xa[i] = xb[i];
        }
        xpose_finish(cur, xa, scr, F.lane);
    }
    if (gw == 0) {
        float* bt = (float*)(F.ws + WS_BIAS);
        for (int i = F.lane; i < 8 * 128; i += 64) { const int h = i >> 7, r = i & 127; bt[i] = (a.rel_bias[(int)T5_BUCKET[r] * 8 + h] - a.rel_bias[31 * 8 + h]) * LOG2E; }
    }
}
__device__ __forceinline__ void p0_convert_stream(Frame& F, const P0Args& a, int xcd) {
    LAS float* scr = nullptr;
    unsigned* ctr = (unsigned*)(F.ctl + CW_QCONV + xcd * 64);
    const int base = P0_I_AB + xcd * P0_NTICK_XCD * P0_TICK;
    int tnraw = 0; if (F.lane == 0) tnraw = (int)__hip_atomic_fetch_add(ctr, 1u, __ATOMIC_RELAXED, __HIP_MEMORY_SCOPE_AGENT);
    int it = 0, left = 0; bool done = false;
    auto gen = [&]() -> int {
        if (done) return -1;
        if (left == 0) { const int tn = __builtin_amdgcn_readfirstlane(tnraw); if (tn >= P0_NTICK_XCD) { done = true; return -1; }
            it = base + tn * P0_TICK; left = P0_TICK; if (F.lane == 0) tnraw = (int)__hip_atomic_fetch_add(ctr, 1u, __ATOMIC_RELAXED, __HIP_MEMORY_SCOPE_AGENT); }
        --left; return it++; };
    f32x4 x0[8], x1[8], x2[8], x3[8];
#define P0_FIN(I, X) xpose_finish(p0_decode(a, F.ws, (I)), X, scr, F.lane)
    int i0 = gen(); if (i0 < 0) return;
    xpose_load(p0_decode(a, F.ws, i0), x0, F.lane);
    int i1 = gen(); if (i1 < 0) { P0_FIN(i0, x0); return; }
    xpose_load(p0_decode(a, F.ws, i1), x1, F.lane);
    int i2 = gen(); if (i2 < 0) { P0_FIN(i0, x0); P0_FIN(i1, x1); return; }
    xpose_load(p0_decode(a, F.ws, i2), x2, F.lane);
#define P0_STEP(XL, XF, XA, XB) { const int in_ = gen(); if (in_ < 0) { P0_FIN(i0, XF); P0_FIN(i1, XA); P0_FIN(i2, XB); return; } \
        xpose_load(p0_decode(a, F.ws, in_), XL, F.lane); P0_FIN(i0, XF); i0 = i1; i1 = i2; i2 = in_; }
    for (;;) { P0_STEP(x3, x0, x1, x2) P0_STEP(x0, x1, x2, x3) P0_STEP(x1, x2, x3, x0) P0_STEP(x2, x3, x0, x1) }
#undef P0_STEP
#undef P0_FIN
}

constexpr int AS_PITCH = 2052;
constexpr int PS_OFF = 131584;
constexpr int AH_PITCH = 2056, AL_OFF = 16 * AH_PITCH * 2;
template <bool COMBINE, int OUTMODE, int SKINNY>
__device__ __forceinline__ void norm16_rows(Frame& F, int task, const float* xin, float* xout, const float* gain, bf16* H, float* OUT,
                                            const int* tokinfo, const float* gates, const bf16* ybuf, const LAS int* tstart) {
    LAS float* A_s = (LAS float*)(F.lds);
#pragma unroll
    for (int rr = 0; rr < 2; ++rr) {
        const int rl = 2 * F.wave + rr, row = 16 * task + rl;
        const GAS f32x4* xr = (const GAS f32x4*)(xin + (size_t)row * D) + F.lane;
        f32x4 v[8];
#pragma unroll
        for (int j = 0; j < 8; ++j) v[j] = xr[64 * j];
        if (COMBINE) {
            const int e0 = tokinfo[4 * row], s0 = tokinfo[4 * row + 1], e1 = tokinfo[4 * row + 2], s1 = tokinfo[4 * row + 3];
            const float g0 = gates[2 * row], g1 = gates[2 * row + 1];
            const size_t r0 = (size_t)(tstart[e0] * 256 + s0), r1 = (size_t)(tstart[e1] * 256 + s1);
            const GAS v2u* y0 = (const GAS v2u*)(ybuf + r0 * D) + F.lane; const GAS v2u* y1 = (const GAS v2u*)(ybuf + r1 * D) + F.lane;
#pragma unroll
            for (int j = 0; j < 8; ++j) { const v2u a = y0[64 * j], b = y1[64 * j];
                v[j].x += g0 * bflo(a.x) + g1 * bflo(b.x); v[j].y += g0 * bfhi(a.x) + g1 * bfhi(b.x); v[j].z += g0 * bflo(a.y) + g1 * bflo(b.y); v[j].w += g0 * bfhi(a.y) + g1 * bfhi(b.y); }
            if (OUTMODE == 0) { GAS f32x4* xo = (GAS f32x4*)(xout + (size_t)row * D) + F.lane;
#pragma unroll
                for (int j = 0; j < 8; ++j) xo[64 * j] = v[j]; }
        }
        float s = 0.f;
#pragma unroll
        for (int j = 0; j < 8; ++j) s += (v[j].x * v[j].x + v[j].y * v[j].y) + (v[j].z * v[j].z + v[j].w * v[j].w);
        const float rstd = 1.0f / sqrtf(wave_sum(s) * (1.f / D) + EPS);
        const GAS f32x4* gr = (const GAS f32x4*)gain + F.lane;
#pragma unroll
        for (int j = 0; j < 8; ++j) { const f32x4 g = gr[64 * j]; v[j] = v[j] * rstd * g; }
        if (OUTMODE == 0) { GAS v2u* o8 = (GAS v2u*)(H + (size_t)row * D) + F.lane;
#pragma unroll
            for (int j = 0; j < 8; ++j) { v2u o; o.x = pk2(v[j].x, v[j].y); o.y = pk2(v[j].z, v[j].w); o8[64 * j] = o; } }
        else { GAS f32x4* oo = (GAS f32x4*)(OUT + (size_t)row * D) + F.lane;
#pragma unroll
            for (int j = 0; j < 8; ++j) oo[64 * j] = v[j]; }
        if (SKINNY == 1) {
#pragma unroll
            for (int j = 0; j < 8; ++j) *(LAS f32x4*)(A_s + rl * AS_PITCH + 4 * (F.lane + 64 * j)) = v[j];
        }
        if (SKINNY == 2) {
            LAS bf16* AH = (LAS bf16*)(F.lds); LAS bf16* AL = (LAS bf16*)(F.lds + AL_OFF);
#pragma unroll
            for (int j = 0; j < 8; ++j) { const unsigned h0 = f2bf(v[j].x), h1 = f2bf(v[j].y), h2 = f2bf(v[j].z), h3 = f2bf(v[j].w);
                const float l0 = v[j].x - __builtin_bit_cast(float, h0 << 16), l1 = v[j].y - __builtin_bit_cast(float, h1 << 16), l2 = v[j].z - __builtin_bit_cast(float, h2 << 16), l3 = v[j].w - __builtin_bit_cast(float, h3 << 16);
                *(LAS v2u*)(AH + rl * AH_PITCH + 4 * (F.lane + 64 * j)) = (v2u){h0 | (h1 << 16), h2 | (h3 << 16)};
                *(LAS v2u*)(AL + rl * AH_PITCH + 4 * (F.lane + 64 * j)) = (v2u){pk2(l0, l1), pk2(l2, l3)}; }
        }
    }
}
template <int NT, class BSrc>
__device__ __forceinline__ void skinny16(Frame& F, const BSrc& bsrc) {
#if defined(DBG_NAIVE_SKINNY)
    {   const LAS float* A_s = (const LAS float*)(F.lds); const int row = F.tid >> 5, c32 = F.tid & 31; float r0 = 0.f, r1 = 0.f;
        for (int k = 0; k < D; ++k) { const float a = A_s[row * AS_PITCH + k]; r0 += a * bsrc(k, c32); if (c32 + 32 < 16 * NT) r1 += a * bsrc(k, c32 + 32); }
        WG_SYNC();
        LAS float* PS = (LAS float*)(F.lds + PS_OFF);
        if (c32 < 16 * NT) PS[row * 48 + c32] = r0; if (c32 + 32 < 16 * NT) PS[row * 48 + c32 + 32] = r1;
        WG_SYNC(); return; }
#endif
    const LAS float* A_s = (const LAS float*)(F.lds);
    const int i = F.lane & 15, kq = F.lane >> 4;
    f32x4 acc[NT];
#pragma unroll
    for (int t = 0; t < NT; ++t) acc[t] = (f32x4){0.f, 0.f, 0.f, 0.f};
    const int kbase = 256 * F.wave;
#pragma unroll 8
    for (int s = 0; s < 64; ++s) {
        const int k = kbase + 4 * s + kq; const float a = A_s[i * AS_PITCH + k];
#pragma unroll
        for (int t = 0; t < NT; ++t) { const float b = bsrc(k, 16 * t + i); acc[t] = __builtin_amdgcn_mfma_f32_16x16x4f32(a, b, acc[t], 0, 0, 0); }
    }
    WG_SYNC();
    LAS float* PP = (LAS float*)(F.lds);
#pragma unroll
    for (int t = 0; t < NT; ++t)
#pragma unroll
        for (int j = 0; j < 4; ++j) PP[((F.wave * NT + t) * 16 + 4 * kq + j) * 16 + i] = acc[t][j];
    WG_SYNC();
    LAS float* PS = (LAS float*)(F.lds + PS_OFF);
    for (int idx = F.tid; idx < NT * 256; idx += NWAVES * 64) { const int t = idx >> 8, rc = idx & 255; float s = 0.f;
#pragma unroll
        for (int w = 0; w < 8; ++w) s += PP[((w * NT + t) * 256) + rc];
        PS[(rc >> 4) * 48 + 16 * t + (rc & 15)] = s; }
    WG_SYNC();
}
__device__ __forceinline__ void skinny16_bf3(Frame& F, const bf16* WH, const bf16* WL) {
    const LAS bf16* AH = (const LAS bf16*)(F.lds); const LAS bf16* AL = (const LAS bf16*)(F.lds + AL_OFF);
    const int i = F.lane & 15, kq = F.lane >> 4;
    f32x4 acc[3];
#pragma unroll
    for (int t = 0; t < 3; ++t) acc[t] = (f32x4){0.f, 0.f, 0.f, 0.f};
#pragma unroll 4
    for (int s = 0; s < 8; ++s) { const int k0 = 32 * (8 * F.wave + s) + 8 * kq;
        const bf16x8 ah = *(const LAS bf16x8*)(AH + i * AH_PITCH + k0), al = *(const LAS bf16x8*)(AL + i * AH_PITCH + k0);
#pragma unroll
        for (int t = 0; t < 3; ++t) { const bf16x8 bh = *(const GAS bf16x8*)(WH + (size_t)(16 * t + i) * D + k0), bl = *(const GAS bf16x8*)(WL + (size_t)(16 * t + i) * D + k0);
            acc[t] = __builtin_amdgcn_mfma_f32_16x16x32_bf16(ah, bh, acc[t], 0, 0, 0);
            acc[t] = __builtin_amdgcn_mfma_f32_16x16x32_bf16(ah, bl, acc[t], 0, 0, 0);
            acc[t] = __builtin_amdgcn_mfma_f32_16x16x32_bf16(al, bh, acc[t], 0, 0, 0); } }
    WG_SYNC();
    LAS float* PP = (LAS float*)(F.lds);
#pragma unroll
    for (int t = 0; t < 3; ++t)
#pragma unroll
        for (int j = 0; j < 4; ++j) PP[((F.wave * 3 + t) * 16 + 4 * kq + j) * 16 + i] = acc[t][j];
    WG_SYNC();
    LAS float* PS = (LAS float*)(F.lds + PS_OFF);
    for (int idx = F.tid; idx < 3 * 256; idx += NWAVES * 64) { const int t = idx >> 8, rc = idx & 255; float s = 0.f;
#pragma unroll
        for (int w = 0; w < 8; ++w) s += PP[((w * 3 + t) * 256) + rc];
        PS[(rc >> 4) * 48 + 16 * t + (rc & 15)] = s; }
    WG_SYNC();
}
__device__ __forceinline__ void p0_router_weights(Frame& F, const float* w_rg, const float* w_re, const float* nffn) {
    bf16* WR = (bf16*)(F.ws + WS_WR);
    for (int idx = (int)blockIdx.x * (NWAVES * 64) + F.tid; idx < 2 * 48 * D; idx += F.G * NWAVES * 64) {
        const int l = idx / (48 * D), r = idx % (48 * D), k = r / 48, c = r % 48;
        const float v = (c < 4 ? w_rg[((size_t)l * D + k) * 4 + c] : (c < 36 ? w_re[((size_t)l * D + k) * 32 + c - 4] : 0.f)) * nffn[(size_t)l * D + k];
        const unsigned h = f2bf(v); const float lo = v - __builtin_bit_cast(float, h << 16);
        WR[((size_t)(l * 2 + 0) * 48 + c) * D + k] = (bf16)h; WR[((size_t)(l * 2 + 1) * 48 + c) * D + k] = (bf16)f2bf(lo); }
}
struct GbSrc { const float* w; __device__ __forceinline__ float operator()(int k, int col) const { return w[(size_t)k * NABX + NAB + col]; } };
struct RouterSrc { const float* wg; const float* we;
    __device__ __forceinline__ float operator()(int k, int col) const { return col < 4 ? wg[k * 4 + col] : (col < 36 ? we[k * 32 + col - 4] : 0.f); } };

__device__ __forceinline__ void route16(Frame& F, int task, int layer) {
    const LAS float* PS = (const LAS float*)(F.lds + PS_OFF);
    LAS int* agg = (LAS int*)(F.lds + PS_OFF + 16 * 48 * 4);
    if (F.tid < 64) {
        if (F.tid < 32) agg[F.tid] = 0;
        LDS_WAIT();
        int row = 0, e0 = 0, e1 = 0, r0 = 0, r1 = 0; float g0 = 0.f, g1 = 0.f;
        if (F.tid < 16) {
            row = 16 * task + F.tid; const LAS float* lg = PS + F.tid * 48;
            int g = 0; float mg = lg[0];
#pragma unroll
            for (int j = 1; j < 4; ++j) { const float x = lg[j]; if (x > mg) { mg = x; g = j; } }
            float sg = 0.f;
#pragma unroll
            for (int j = 0; j < 4; ++j) sg += expf(lg[j] - mg);
            const float pg = 1.0f / sg;
            const LAS float* le = lg + 4 + 8 * g;
            int i0 = 0; float m0 = le[0];
#pragma unroll
            for (int j = 1; j < 8; ++j) { const float x = le[j]; if (x > m0) { m0 = x; i0 = j; } }
            int i1 = -1; float m1 = -INFINITY;
#pragma unroll
            for (int j = 0; j < 8; ++j) { const float x = le[j]; if (j != i0 && x > m1) { m1 = x; i1 = j; } }
            const float p1 = expf(m1 - m0), inv = 1.0f / (1.0f + p1);
            e0 = 8 * g + i0; e1 = 8 * g + i1; g0 = pg * inv; g1 = pg * p1 * inv;
            r0 = __hip_atomic_fetch_add(agg + e0, 1, __ATOMIC_RELAXED, __HIP_MEMORY_SCOPE_WORKGROUP);
            r1 = __hip_atomic_fetch_add(agg + e1, 1, __ATOMIC_RELAXED, __HIP_MEMORY_SCOPE_WORKGROUP);
        }
        LDS_WAIT();
        if (F.tid < 32) { const int c = agg[F.tid]; if (c > 0) agg[32 + F.tid] = (int)atomicAdd((unsigned*)(F.ctl + CW_CNT + layer * 2048) + F.tid * 64, (unsigned)c); }
        LDS_WAIT();
        if (F.tid < 16) {
            const int s0 = agg[32 + e0] + r0, s1 = agg[32 + e1] + r1;
            int* list = (int*)(F.ws + WS_LIST); int* tok = (int*)(F.ws + WS_TOK); float* gates = (float*)(F.ws + WS_TOK + 262144);
            list[e0 * 8192 + s0] = row; list[e1 * 8192 + s1] = row;
            tok[4 * row] = e0; tok[4 * row + 1] = s0; tok[4 * row + 2] = e1; tok[4 * row + 3] = s1;
            gates[2 * row] = g0; gates[2 * row + 1] = g1;
        }
    }
}
__device__ __forceinline__ void router_pair(Frame& F, int layer, const float* X, const bf16* DL, const float* gain, bf16* H, const bf16* WH, const bf16* WL) {
    const int lane = F.lane, i = lane & 15, g = lane >> 4, w = F.wave;
    const int t0 = F.vcu, t1 = F.vcu + F.G;
    const int kb = 256 * w + 8 * g;
    const GAS f32x4* xr0 = (const GAS f32x4*)(X + (size_t)(16 * t0 + i) * D + kb); const GAS f32x4* xr1 = (const GAS f32x4*)(X + (size_t)(16 * t1 + i) * D + kb);
    f32x4 xa[2][8][2];
#pragma unroll
    for (int s = 0; s < 8; ++s) { xa[0][s][0] = xr0[8 * s]; xa[0][s][1] = xr0[8 * s + 1]; xa[1][s][0] = xr1[8 * s]; xa[1][s][1] = xr1[8 * s + 1]; }
    if (DL != nullptr) {   const GAS v4u* d0 = (const GAS v4u*)(DL + (size_t)(16 * t0 + i) * D + kb); const GAS v4u* d1 = (const GAS v4u*)(DL + (size_t)(16 * t1 + i) * D + kb);
        v4u da[2][8];
#pragma unroll
        for (int s = 0; s < 8; ++s) { da[0][s] = d0[4 * s]; da[1][s] = d1[4 * s]; }
#pragma unroll
        for (int rg = 0; rg < 2; ++rg)
#pragma unroll
            for (int s = 0; s < 8; ++s) { const v4u q = da[rg][s]; f32x4& a = xa[rg][s][0]; f32x4& b = xa[rg][s][1];
                a.x += bflo(q.x); a.y += bfhi(q.x); a.z += bflo(q.y); a.w += bfhi(q.y); b.x += bflo(q.z); b.y += bfhi(q.z); b.z += bflo(q.w); b.w += bfhi(q.w); } }
#pragma unroll
    for (int s = 0; s < 8; ++s) asm volatile("" : "+v"(xa[0][s][0]), "+v"(xa[0][s][1]), "+v"(xa[1][s][0]), "+v"(xa[1][s][1]));
    f32x4 acc[2][3]; float ss[2] = {0.f, 0.f};
#pragma unroll
    for (int rg = 0; rg < 2; ++rg)
#pragma unroll
        for (int t = 0; t < 3; ++t) acc[rg][t] = (f32x4){0.f, 0.f, 0.f, 0.f};
#pragma unroll
    for (int s = 0; s < 8; ++s) { const int k0 = kb + 32 * s;
        if ((s & 1) == 0) asm volatile("" ::: "memory");
        bf16x8 bh[3], bl[3];
#pragma unroll
        for (int t = 0; t < 3; ++t) { bh[t] = *(const GAS bf16x8*)(WH + (size_t)(16 * t + i) * D + k0); bl[t] = *(const GAS bf16x8*)(WL + (size_t)(16 * t + i) * D + k0); }
#pragma unroll
        for (int rg = 0; rg < 2; ++rg) { const f32x4 a = xa[rg][s][0], b = xa[rg][s][1];
            ss[rg] += (a.x * a.x + a.y * a.y) + (a.z * a.z + a.w * a.w) + (b.x * b.x + b.y * b.y) + (b.z * b.z + b.w * b.w);
            v4u hi, lo; hi.x = cvtpk_hw(a.x, a.y); hi.y = cvtpk_hw(a.z, a.w); hi.z = cvtpk_hw(b.x, b.y); hi.w = cvtpk_hw(b.z, b.w);
            lo.x = cvtpk_hw(a.x - bflo(hi.x), a.y - bfhi(hi.x)); lo.y = cvtpk_hw(a.z - bflo(hi.y), a.w - bfhi(hi.y)); lo.z = cvtpk_hw(b.x - bflo(hi.z), b.y - bfhi(hi.z)); lo.w = cvtpk_hw(b.z - bflo(hi.w), b.w - bfhi(hi.w));
            const bf16x8 ah = __builtin_bit_cast(bf16x8, hi), al = __builtin_bit_cast(bf16x8, lo);
#pragma unroll
            for (int t = 0; t < 3; ++t) { acc[rg][t] = __builtin_amdgcn_mfma_f32_16x16x32_bf16(ah, bh[t], acc[rg][t], 0, 0, 0);
                acc[rg][t] = __builtin_amdgcn_mfma_f32_16x16x32_bf16(ah, bl[t], acc[rg][t], 0, 0, 0);
                acc[rg][t] = __builtin_amdgcn_mfma_f32_16x16x32_bf16(al, bh[t], acc[rg][t], 0, 0, 0); } } }
    LAS float* PP = (LAS float*)(F.lds);
    LAS float* SS = (LAS float*)(F.lds + 49152);
    LAS float* PS = (LAS float*)(F.lds + PS_OFF);
    LAS float* RSTD = (LAS float*)(F.lds + PS_OFF + 32 * 48 * 4);
    LAS int* agg = (LAS int*)(F.lds + PS_OFF + 32 * 48 * 4 + 128);
#pragma unroll
    for (int rg = 0; rg < 2; ++rg) { float q = ss[rg]; q += __shfl_xor(q, 16); q += __shfl_xor(q, 32); if (g == 0) SS[w * 32 + 16 * rg + i] = q;
#pragma unroll
        for (int t = 0; t < 3; ++t)
#pragma unroll
            for (int j = 0; j < 4; ++j) PP[(((w * 2 + rg) * 3 + t) * 16 + 4 * g + j) * 16 + i] = acc[rg][t][j]; }
    WG_SYNC();
    for (int idx = F.tid; idx < 2 * 768; idx += NWAVES * 64) { const int rg = idx >= 768, r2 = idx - 768 * rg, t = r2 >> 8, rc = r2 & 255; float q = 0.f;
#pragma unroll
        for (int ww = 0; ww < 8; ++ww) q += PP[((ww * 2 + rg) * 3 + t) * 256 + rc];
        PS[(16 * rg + (rc >> 4)) * 48 + 16 * t + (rc & 15)] = q; }
    if (F.tid < 32) { float q = 0.f;
#pragma unroll
        for (int ww = 0; ww < 8; ++ww) q += SS[ww * 32 + F.tid];
        RSTD[F.tid] = 1.0f / sqrtf(q * (1.f / D) + EPS); agg[F.tid] = 0; }
    WG_SYNC();
    {   const float r0 = RSTD[i], r1 = RSTD[16 + i];
        int i2 = lane & 15, kb2 = 256 * w + 8 * (lane >> 4); asm volatile("" : "+v"(i2), "+v"(kb2));
        bf16* h0 = H + (size_t)(16 * t0 + i2) * D + kb2; bf16* h1 = H + (size_t)(16 * t1 + i2) * D + kb2; const GAS f32x4* gp = (const GAS f32x4*)(gain + kb2);
#pragma unroll
        for (int s = 0; s < 8; ++s) { const f32x4 ga = gp[8 * s], gb = gp[8 * s + 1];
            { const f32x4 a = xa[0][s][0], b = xa[0][s][1]; v4u o; o.x = cvtpk_hw(a.x * r0 * ga.x, a.y * r0 * ga.y); o.y = cvtpk_hw(a.z * r0 * ga.z, a.w * r0 * ga.w); o.z = cvtpk_hw(b.x * r0 * gb.x, b.y * r0 * gb.y); o.w = cvtpk_hw(b.z * r0 * gb.z, b.w * r0 * gb.w);
              *(v4u*)(h0 + 32 * s) = o; }
            { const f32x4 a = xa[1][s][0], b = xa[1][s][1]; v4u o; o.x = cvtpk_hw(a.x * r1 * ga.x, a.y * r1 * ga.y); o.y = cvtpk_hw(a.z * r1 * ga.z, a.w * r1 * ga.w); o.z = cvtpk_hw(b.x * r1 * gb.x, b.y * r1 * gb.y); o.w = cvtpk_hw(b.z * r1 * gb.z, b.w * r1 * gb.w);
              *(v4u*)(h1 + 32 * s) = o; } } }
    if (F.tid < 64) {
        int row = 0, e0 = 0, e1 = 0, q0 = 0, q1 = 0; float g0 = 0.f, g1 = 0.f;
        if (F.tid < 32) {
            row = (F.tid < 16 ? 16 * t0 : 16 * t1 - 16) + F.tid; const LAS float* lg = PS + F.tid * 48; const float rs = RSTD[F.tid];
            int gi = 0; float mg = lg[0] * rs;
#pragma unroll
            for (int j = 1; j < 4; ++j) { const float x = lg[j] * rs; if (x > mg) { mg = x; gi = j; } }
            float sg = 0.f;
#pragma unroll
            for (int j = 0; j < 4; ++j) sg += expf(lg[j] * rs - mg);
            const float pg = 1.0f / sg;
            const LAS float* le = lg + 4 + 8 * gi;
            int i0 = 0; float m0 = le[0] * rs;
#pragma unroll
            for (int j = 1; j < 8; ++j) { const float x = le[j] * rs; if (x > m0) { m0 = x; i0 = j; } }
            int i1 = -1; float m1 = -INFINITY;
#pragma unroll
            for (int j = 0; j < 8; ++j) { const float x = le[j] * rs; if (j != i0 && x > m1) { m1 = x; i1 = j; } }
            const float p1 = expf(m1 - m0), inv = 1.0f / (1.0f + p1);
            e0 = 8 * gi + i0; e1 = 8 * gi + i1; g0 = pg * inv; g1 = pg * p1 * inv;
            q0 = __hip_atomic_fetch_add(agg + e0, 1, __ATOMIC_RELAXED, __HIP_MEMORY_SCOPE_WORKGROUP);
            q1 = __hip_atomic_fetch_add(agg + e1, 1, __ATOMIC_RELAXED, __HIP_MEMORY_SCOPE_WORKGROUP);
        }
        LDS_WAIT();
        if (F.tid < 32) { const int c = agg[F.tid]; if (c > 0) agg[32 + F.tid] = (int)atomicAdd((unsigned*)(F.ctl + CW_CNT + layer * 2048) + F.tid * 64, (unsigned)c); }
        LDS_WAIT();
        if (F.tid < 32) {
            const int s0 = agg[32 + e0] + q0, s1 = agg[32 + e1] + q1;
            int* list = (int*)(F.ws + WS_LIST); int* tok = (int*)(F.ws + WS_TOK); float* gates = (float*)(F.ws + WS_TOK + 262144);
            list[e0 * 8192 + s0] = row; list[e1 * 8192 + s1] = row;
            tok[4 * row] = e0; tok[4 * row + 1] = s0; tok[4 * row + 2] = e1; tok[4 * row + 3] = s1;
            gates[2 * row] = g0; gates[2 * row + 1] = g1;
        }
    }
    WG_SYNC();
}
__device__ __forceinline__ void p0_norm_pair(Frame& F, const float* X, const float* gain, const float* w_in_ab, bf16* H, float* GB) {
    const int lane = F.lane, i = lane & 15, g = lane >> 4, w = F.wave;
    const int t0 = F.vcu, t1 = F.vcu + F.G;
    const int kb = 256 * w + 8 * g;
    const GAS f32x4* xr0 = (const GAS f32x4*)(X + (size_t)(16 * t0 + i) * D + kb); const GAS f32x4* xr1 = (const GAS f32x4*)(X + (size_t)(16 * t1 + i) * D + kb);
    f32x4 xa[2][8][2];
#pragma unroll
    for (int s = 0; s < 8; ++s) { xa[0][s][0] = xr0[8 * s]; xa[0][s][1] = xr0[8 * s + 1]; xa[1][s][0] = xr1[8 * s]; xa[1][s][1] = xr1[8 * s + 1]; }
    f32x4 acc[2] = {(f32x4){0.f, 0.f, 0.f, 0.f}, (f32x4){0.f, 0.f, 0.f, 0.f}}; float ss[2] = {0.f, 0.f};
    const GAS f32x4* gp = (const GAS f32x4*)(gain + kb);
#pragma unroll
    for (int s = 0; s < 8; ++s) { const int k0 = kb + 32 * s;
        if ((s & 1) == 0) asm volatile("" ::: "memory");
        const f32x4 ga = gp[8 * s], gb = gp[8 * s + 1];
        float wv[8];
#pragma unroll
        for (int j = 0; j < 8; ++j) wv[j] = w_in_ab[(size_t)(k0 + j) * NABX + NAB + i];
        wv[0] *= ga.x; wv[1] *= ga.y; wv[2] *= ga.z; wv[3] *= ga.w; wv[4] *= gb.x; wv[5] *= gb.y; wv[6] *= gb.z; wv[7] *= gb.w;
        v4u whi, wlo; whi.x = cvtpk_hw(wv[0], wv[1]); whi.y = cvtpk_hw(wv[2], wv[3]); whi.z = cvtpk_hw(wv[4], wv[5]); whi.w = cvtpk_hw(wv[6], wv[7]);
        wlo.x = cvtpk_hw(wv[0] - bflo(whi.x), wv[1] - bfhi(whi.x)); wlo.y = cvtpk_hw(wv[2] - bflo(whi.y), wv[3] - bfhi(whi.y)); wlo.z = cvtpk_hw(wv[4] - bflo(whi.z), wv[5] - bfhi(whi.z)); wlo.w = cvtpk_hw(wv[6] - bflo(whi.w), wv[7] - bfhi(whi.w));
        const bf16x8 bh = __builtin_bit_cast(bf16x8, whi), bl = __builtin_bit_cast(bf16x8, wlo);
#pragma unroll
        for (int rg = 0; rg < 2; ++rg) { const f32x4 a = xa[rg][s][0], b = xa[rg][s][1];
            ss[rg] += (a.x * a.x + a.y * a.y) + (a.z * a.z + a.w * a.w) + (b.x * b.x + b.y * b.y) + (b.z * b.z + b.w * b.w);
            v4u hi, lo; hi.x = cvtpk_hw(a.x, a.y); hi.y = cvtpk_hw(a.z, a.w); hi.z = cvtpk_hw(b.x, b.y); hi.w = cvtpk_hw(b.z, b.w);
            lo.x = cvtpk_hw(a.x - bflo(hi.x), a.y - bfhi(hi.x)); lo.y = cvtpk_hw(a.z - bflo(hi.y), a.w - bfhi(hi.y)); lo.z = cvtpk_hw(b.x - bflo(hi.z), b.y - bfhi(hi.z)); lo.w = cvtpk_hw(b.z - bflo(hi.w), b.w - bfhi(hi.w));
            const bf16x8 ah = __builtin_bit_cast(bf16x8, hi), al = __builtin_bit_cast(bf16x8, lo);
            acc[rg] = __builtin_amdgcn_mfma_f32_16x16x32_bf16(ah, bh, acc[rg], 0, 0, 0);
            acc[rg] = __builtin_amdgcn_mfma_f32_16x16x32_bf16(ah, bl, acc[rg], 0, 0, 0);
            acc[rg] = __builtin_amdgcn_mfma_f32_16x16x32_bf16(al, bh, acc[rg], 0, 0, 0); } }
    LAS float* PP = (LAS float*)(F.lds);
    LAS float* SS = (LAS float*)(F.lds + 16384);
    LAS float* RSTD = (LAS float*)(F.lds + 16384 + 1024);
#pragma unroll
    for (int rg = 0; rg < 2; ++rg) { float q = ss[rg]; q += __shfl_xor(q, 16); q += __shfl_xor(q, 32); if (g == 0) SS[w * 32 + 16 * rg + i] = q;
#pragma unroll
        for (int j = 0; j < 4; ++j) PP[((w * 2 + rg) * 16 + 4 * g + j) * 16 + i] = acc[rg][j]; }
    WG_SYNC();
    if (F.tid < 32) { float q = 0.f;
#pragma unroll
        for (int ww = 0; ww < 8; ++ww) q += SS[ww * 32 + F.tid];
        RSTD[F.tid] = 1.0f / sqrtf(q * (1.f / D) + EPS); }
    WG_SYNC();
    {   const int rg = F.tid >> 8, rc = F.tid & 255, tokl = rc >> 4; float q = 0.f;
#pragma unroll
        for (int ww = 0; ww < 8; ++ww) q += PP[(ww * 2 + rg) * 256 + rc];
        GB[(size_t)((rg ? 16 * t1 : 16 * t0) + tokl) * 16 + (rc & 15)] = q * RSTD[16 * rg + tokl]; }
    {   const float r0 = RSTD[i], r1 = RSTD[16 + i];
        bf16* h0 = H + (size_t)(16 * t0 + i) * D + kb; bf16* h1 = H + (size_t)(16 * t1 + i) * D + kb;
#pragma unroll
        for (int s = 0; s < 8; ++s) { const f32x4 ga = gp[8 * s], gb = gp[8 * s + 1];
            { const f32x4 a = xa[0][s][0], b = xa[0][s][1]; v4u o; o.x = cvtpk_hw(a.x * r0 * ga.x, a.y * r0 * ga.y); o.y = cvtpk_hw(a.z * r0 * ga.z, a.w * r0 * ga.w); o.z = cvtpk_hw(b.x * r0 * gb.x, b.y * r0 * gb.y); o.w = cvtpk_hw(b.z * r0 * gb.z, b.w * r0 * gb.w);
              *(v4u*)(h0 + 32 * s) = o; }
            { const f32x4 a = xa[1][s][0], b = xa[1][s][1]; v4u o; o.x = cvtpk_hw(a.x * r1 * ga.x, a.y * r1 * ga.y); o.y = cvtpk_hw(a.z * r1 * ga.z, a.w * r1 * ga.w); o.z = cvtpk_hw(b.x * r1 * gb.x, b.y * r1 * gb.y); o.w = cvtpk_hw(b.z * r1 * gb.z, b.w * r1 * gb.w);
              *(v4u*)(h1 + 32 * s) = o; } } }
    WG_SYNC();
}
__device__ __forceinline__ void moe_tables(Frame& F, int layer) {
    LAS int* cntL = (LAS int*)(F.lds + MOE_OFF); LAS int* ts = cntL + 32; LAS int* mte = ts + 33; LAS int* mts = mte + 96; LAS int* el = cntL + 257; LAS int* ll = cntL + 353; LAS int* cov = cntL + 451;
    if (F.tid < 32) {
        const int e = F.tid; const int c = (int)__hip_atomic_load(F.ctl + CW_CNT + layer * 2048 + e * 64, RLX_AGENT); cntL[e] = c; const int nt = (c + 255) >> 8;
        int incl = nt;
#pragma unroll
        for (int o = 1; o < 32; o <<= 1) { const int v = __shfl_up(incl, o); if (e >= o) incl += v; }
        const int excl = incl - nt; ts[e] = excl; if (e == 31) ts[32] = incl > 96 ? 96 : incl;
        for (int t = 0; t < nt; ++t) { if (excl + t < 96) { mte[excl + t] = e; mts[excl + t] = 256 * t; } }
    }
    if (F.tid < 384) cov[F.tid] = 0;
    WG_SYNC();
    const int U = ts[32] * 4;
    if (F.tid < 256 && F.tid < U) cov[pg8::xcd_remap(F.tid, U)] = 1;
    WG_SYNC();
    if (F.tid < 64) {
        const int tm = ts[32]; int ne = 0, nl = 0;
#pragma unroll
        for (int r = 0; r < 2; ++r) { const int mt = F.tid + 64 * r; const bool valid = mt < tm;
            const bool early = valid && (cov[4 * (valid ? mt : 0)] & cov[4 * (valid ? mt : 0) + 1] & cov[4 * (valid ? mt : 0) + 2] & cov[4 * (valid ? mt : 0) + 3]);
            const bool late = valid && !early;
            const unsigned long long be = __ballot(early), bl = __ballot(late), lt = (1ull << F.tid) - 1ull;
            if (early) el[ne + __popcll(be & lt)] = mt;
            if (late) ll[nl + __popcll(bl & lt)] = mt;
            ne += __popcll(be); nl += __popcll(bl); }
        if (F.tid == 0) { cntL[449] = ne; cntL[450] = nl; } }
    WG_SYNC();
}

__device__ __forceinline__ float fmac1(float d, float a, float b) { asm("v_fmac_f32_e32 %0, %1, %2" : "+v"(d) : "v"(a), "v"(b)); return d; }
#define R4_FMA4(A, S, W) do { (A).x = fmac1((A).x, (S), (W).x); (A).y = fmac1((A).y, (S), (W).y); (A).z = fmac1((A).z, (S), (W).z); (A).w = fmac1((A).w, (S), (W).w); } while (0)
template <bool COMBINE, int OUTMODE, int NG, class BSrc4, int NR = 4>
__device__ __forceinline__ void rows4(Frame& F, int r0, const float* xin, float* xout, const float* gain, bf16* H, float* OUT,
                                      const int* tokinfo, const float* gates, const bf16* ybuf, const LAS int* tstart, const BSrc4& bs, float* sel, const bf16* dl = nullptr) {
    const int lane = F.lane;
    f32x4 v[NR][8];
#pragma unroll
    for (int r = 0; r < NR; ++r) { const GAS f32x4* xr = (const GAS f32x4*)(xin + (size_t)(r0 + r) * D) + lane;
#pragma unroll
        for (int j = 0; j < 8; ++j) v[r][j] = xr[64 * j]; }
    if (COMBINE) {
        if (dl != nullptr)
#pragma unroll
        for (int r = 0; r < NR; ++r) { const GAS v2u* dr = (const GAS v2u*)(dl + (size_t)(r0 + r) * D) + lane;
#pragma unroll
            for (int j = 0; j < 8; ++j) { const v2u q = dr[64 * j]; v[r][j].x += bflo(q.x); v[r][j].y += bfhi(q.x); v[r][j].z += bflo(q.y); v[r][j].w += bfhi(q.y); } }
#pragma unroll
        for (int r = 0; r < NR; ++r) { const int row = r0 + r;
            const int e0 = tokinfo[4 * row], s0 = tokinfo[4 * row + 1], e1 = tokinfo[4 * row + 2], s1 = tokinfo[4 * row + 3];
            const float g0 = gates[2 * row], g1 = gates[2 * row + 1];
            const size_t q0 = (size_t)(tstart[e0] * 256 + s0), q1 = (size_t)(tstart[e1] * 256 + s1);
            const int odd = lane & 1; const size_t yo = (size_t)((lane >> 1) * 8 + 256 * odd);
            const GAS v4u* y0 = (const GAS v4u*)(ybuf + q0 * D + yo); const GAS v4u* y1 = (const GAS v4u*)(ybuf + q1 * D + yo);
#pragma unroll
            for (int t = 0; t < 4; ++t) { const v4u a = y0[64 * t], b = y1[64 * t];
                const unsigned ag0 = odd ? a.x : a.z, ag1 = odd ? a.y : a.w, bg0 = odd ? b.x : b.z, bg1 = odd ? b.y : b.w;
                const unsigned ar0 = (unsigned)__builtin_amdgcn_mov_dpp((int)ag0, 0xB1, 0xF, 0xF, true), ar1 = (unsigned)__builtin_amdgcn_mov_dpp((int)ag1, 0xB1, 0xF, 0xF, true);
                const unsigned br0 = (unsigned)__builtin_amdgcn_mov_dpp((int)bg0, 0xB1, 0xF, 0xF, true), br1 = (unsigned)__builtin_amdgcn_mov_dpp((int)bg1, 0xB1, 0xF, 0xF, true);
                const unsigned ae0 = odd ? ar0 : a.x, ae1 = odd ? ar1 : a.y, ao0 = odd ? a.z : ar0, ao1 = odd ? a.w : ar1;
                const unsigned be0 = odd ? br0 : b.x, be1 = odd ? br1 : b.y, bo0 = odd ? b.z : br0, bo1 = odd ? b.w : br1;
                { f32x4& w = v[r][2 * t]; w.x += g0 * bflo(ae0) + g1 * bflo(be0); w.y += g0 * bfhi(ae0) + g1 * bfhi(be0); w.z += g0 * bflo(ae1) + g1 * bflo(be1); w.w += g0 * bfhi(ae1) + g1 * bfhi(be1); }
                { f32x4& w = v[r][2 * t + 1]; w.x += g0 * bflo(ao0) + g1 * bflo(bo0); w.y += g0 * bfhi(ao0) + g1 * bfhi(bo0); w.z += g0 * bflo(ao1) + g1 * bflo(bo1); w.w += g0 * bfhi(ao1) + g1 * bfhi(bo1); } }
            if (OUTMODE == 0) { GAS f32x4* xo = (GAS f32x4*)(xout + (size_t)row * D) + lane;
#pragma unroll
                for (int j = 0; j < 8; ++j) xo[64 * j] = v[r][j]; } }
    }
    float rstd[NR];
#pragma unroll
    for (int r = 0; r < NR; ++r) { float s = 0.f;
#pragma unroll
        for (int j = 0; j < 8; ++j) s += (v[r][j].x * v[r][j].x + v[r][j].y * v[r][j].y) + (v[r][j].z * v[r][j].z + v[r][j].w * v[r][j].w);
        rstd[r] = 1.0f / sqrtf(wave_sum(s) * (1.f / D) + EPS); }
    { const GAS f32x4* gr = (const GAS f32x4*)gain + lane;
#pragma unroll
      for (int j = 0; j < 8; ++j) { const f32x4 g = gr[64 * j];
#pragma unroll
          for (int r = 0; r < NR; ++r) v[r][j] = v[r][j] * rstd[r] * g; } }
#pragma unroll
    for (int r = 0; r < NR; ++r) {
        if (OUTMODE == 0) { GAS v2u* o8 = (GAS v2u*)(H + (size_t)(r0 + r) * D) + lane;
#pragma unroll
            for (int j = 0; j < 8; ++j) { v2u o; o.x = pk2(v[r][j].x, v[r][j].y); o.y = pk2(v[r][j].z, v[r][j].w); o8[64 * j] = o; if (NG > 0) __builtin_amdgcn_sched_barrier(0); } }
        else { GAS f32x4* oo = (GAS f32x4*)(OUT + (size_t)(r0 + r) * D) + lane;
#pragma unroll
            for (int j = 0; j < 8; ++j) oo[64 * j] = v[r][j]; } }
    if (NG > 0) {
        static_assert(NG == 0 || NR == 4, "the skinny product is written for 4 rows");
        LAS float* ls = (LAS float*)(F.lds) + F.wave * 256;
#pragma unroll 1
        for (int g = 0; g < NG; ++g) {
            f32x4 acc[4];
#pragma unroll
            for (int r = 0; r < 4; ++r) acc[r] = (f32x4){0.f, 0.f, 0.f, 0.f};
            const GAS char* ub = (const GAS char*)bs.base(g); const unsigned st = bs.stride(g);
            unsigned vo = (unsigned)(4 * lane) * st; asm volatile("" : "+v"(vo));
#define R4_LD(j, q) (*(const GAS f32x4*)(ub + (size_t)((256u * (j) + (q)) * st) + vo))
#pragma unroll
            for (int j = 0; j < 8; ++j) {
                const f32x4 w0 = R4_LD(j, 0), w1 = R4_LD(j, 1), w2 = R4_LD(j, 2), w3 = R4_LD(j, 3);
#pragma unroll
                for (int r = 0; r < 4; ++r) { R4_FMA4(acc[r], v[r][j].x, w0); R4_FMA4(acc[r], v[r][j].y, w1); R4_FMA4(acc[r], v[r][j].z, w2); R4_FMA4(acc[r], v[r][j].w, w3); }
                asm volatile("" ::: "memory");
            }
#undef R4_LD
#pragma unroll
            for (int o = 1; o < 64; o <<= 1)
#pragma unroll
                for (int r = 0; r < 4; ++r) { acc[r].x += __shfl_xor(acc[r].x, o); acc[r].y += __shfl_xor(acc[r].y, o); acc[r].z += __shfl_xor(acc[r].z, o); acc[r].w += __shfl_xor(acc[r].w, o); }
            if (lane < 4) { const f32x4 m = lane == 0 ? acc[0] : (lane == 1 ? acc[1] : (lane == 2 ? acc[2] : acc[3])); *(LAS f32x4*)(ls + lane * 64 + 4 * g) = m; }
        }
        asm volatile("s_waitcnt lgkmcnt(0)" ::: "memory");
        if (lane < 4) {
#pragma unroll
            for (int i = 0; i < NG; ++i) { const f32x4 m = *(const LAS f32x4*)(ls + lane * 64 + 4 * i); sel[4 * i] = m.x; sel[4 * i + 1] = m.y; sel[4 * i + 2] = m.z; sel[4 * i + 3] = m.w; }
        }
    }
}
struct NoSrc4 { __device__ __forceinline__ const float* base(int) const { return nullptr; } __device__ __forceinline__ unsigned stride(int) const { return 0u; } };
struct GbSrc4 { const float* w; __device__ __forceinline__ const float* base(int g) const { return w + NAB + 4 * g; } __device__ __forceinline__ unsigned stride(int) const { return NABX * 4u; } };
struct RouterSrc4 { const float* wg; const float* we;
    __device__ __forceinline__ const float* base(int g) const { return g == 0 ? wg : we + 4 * (g - 1); } __device__ __forceinline__ unsigned stride(int g) const { return g == 0 ? 16u : 128u; } };

__device__ __forceinline__ void route_lane(Frame& F, int row, const float* sel, int layer) {
    int g = 0; float mg = sel[0];
#pragma unroll
    for (int j = 1; j < 4; ++j) { if (sel[j] > mg) { mg = sel[j]; g = j; } }
    float sg = 0.f;
#pragma unroll
    for (int j = 0; j < 4; ++j) sg += expf(sel[j] - mg);
    const float pg = 1.0f / sg;
    float le[8];
#pragma unroll
    for (int j = 0; j < 8; ++j) le[j] = g == 0 ? sel[4 + j] : (g == 1 ? sel[12 + j] : (g == 2 ? sel[20 + j] : sel[28 + j]));
    int i0 = 0; float m0 = le[0];
#pragma unroll
    for (int j = 1; j < 8; ++j) { if (le[j] > m0) { m0 = le[j]; i0 = j; } }
    int i1 = -1; float m1 = -INFINITY;
#pragma unroll
    for (int j = 0; j < 8; ++j) { if (j != i0 && le[j] > m1) { m1 = le[j]; i1 = j; } }
    const float p1 = expf(m1 - m0), inv = 1.0f / (1.0f + p1);
    const int e0 = 8 * g + i0, e1 = 8 * g + i1;
    unsigned* cnt = (unsigned*)(F.ctl + CW_CNT + layer * 2048);
    const int s0 = (int)atomicAdd(cnt + e0 * 64, 1u), s1 = (int)atomicAdd(cnt + e1 * 64, 1u);
    int* list = (int*)(F.ws + WS_LIST); int* tok = (int*)(F.ws + WS_TOK); float* gates = (float*)(F.ws + WS_TOK + 262144);
    list[e0 * 8192 + s0] = row; list[e1 * 8192 + s1] = row;
    tok[4 * row] = e0; tok[4 * row + 1] = s0; tok[4 * row + 2] = e1; tok[4 * row + 3] = s1;
    gates[2 * row] = pg * inv; gates[2 * row + 1] = pg * p1 * inv;
}

__device__ __forceinline__ bf16x8 frag16(const LAS bf16* X, int pitch, int row0, int k0, int lane) { return *(const LAS bf16x8*)(X + (row0 + (lane & 15)) * pitch + k0 + 8 * (lane >> 4)); }
#define MFMA16(a, b, c) __builtin_amdgcn_mfma_f32_16x16x32_bf16((a), (b), (c), 0, 0, 0)

struct GlaArgs { const float* w_gk; const float* b_gk; };
__device__ __forceinline__ float fexp(float x) { return __builtin_amdgcn_exp2f(x * 1.4426950408889634f); }
__device__ __forceinline__ float log_sigmoid(float x) { return fminf(x, 0.f) - 0.6931471805599453f * __builtin_amdgcn_logf(1.0f + fexp(-fabsf(x))); }
__device__ __forceinline__ void gla_a_unit(Frame& F, int unit, const GlaArgs& ga) {
    const int bh = unit >> 6, c = unit & 63, b = bh >> 2, h = bh & 3; const int row0 = b * SEQ + c * 64;
    const bf16* proj = (const bf16*)(F.ws + WS_PROJ); const float* gb = (const float*)(F.ws + WS_GB);
    bf16* GQ = (bf16*)(F.ws + WS_GQ); bf16* GK = (bf16*)(F.ws + WS_GK); float* DEC = (float*)(F.ws + WS_DEC); bf16* DS = (bf16*)(F.ws + WS_DS);
    LAS float* GBs = (LAS float*)(F.lds);
    LAS float* TOT = (LAS float*)(F.lds + 4096);
    LAS float* DECs = (LAS float*)(F.lds + 6144);
    LAS bf16* VT = (LAS bf16*)(F.lds + 8192);
    LAS bf16* KT = (LAS bf16*)(F.lds + 8192 + 36864);
    const int tid = F.tid;
    if (tid < 256) *(LAS f32x4*)(GBs + 4 * tid) = *(const GAS f32x4*)(gb + (size_t)row0 * 16 + 4 * tid);
    const int d = tid & 127, tq = tid >> 7;
    float wg[16];
#pragma unroll
    for (int r = 0; r < 16; ++r) wg[r] = ga.w_gk[r * 512 + h * 128 + d];
    const float bias = ga.b_gk[h * 128 + d];
    WG_SYNC();
    float bl[16]; float run = 0.f;
#pragma unroll
    for (int j = 0; j < 16; ++j) { const LAS float* g = GBs + (16 * tq + j) * 16; float x = bias;
#pragma unroll
        for (int r = 0; r < 16; ++r) x += g[r] * wg[r];
        run += log_sigmoid(x) * (1.0f / 16.0f); bl[j] = run; }
    TOT[tq * 128 + d] = run;
    WG_SYNC();
    float pre = 0.f, tot = 0.f;
#pragma unroll
    for (int q = 0; q < 4; ++q) { const float x = TOT[q * 128 + d]; tot += x; if (q < tq) pre += x; }
    if (tq == 0) { const float dc = fexp(tot); DECs[d] = dc; DEC[(size_t)(bh * 64 + c) * 128 + d] = dc; }
    unsigned kpk[8];
#pragma unroll
    for (int j = 0; j < 16; ++j) { const int t = 16 * tq + j; const size_t row = (size_t)(row0 + t);
        const float bb = pre + bl[j];
        const float q = bf2f(proj[row * NAB + C_QB + h * 128 + d]), k = bf2f(proj[row * NAB + C_KB + h * 128 + d]);
        const float qt = q * 0.08838834764831845f * fexp(bb), kt = k * fexp(-bb);
        const unsigned kb16 = f2bf(kt);
        GQ[row * 512 + h * 128 + d] = (bf16)f2bf(qt); GK[row * 512 + h * 128 + d] = (bf16)kb16;
        if (j & 1) kpk[j >> 1] |= kb16 << 16; else kpk[j >> 1] = kb16; }
    { LAS v4u* dst = (LAS v4u*)(KT + d * 72 + 16 * tq); dst[0] = (v4u){kpk[0], kpk[1], kpk[2], kpk[3]}; dst[1] = (v4u){kpk[4], kpk[5], kpk[6], kpk[7]}; }
    {
        const int e = tid & 255, th = tid >> 8; unsigned vp[16];
#pragma unroll
        for (int j = 0; j < 32; ++j) { const unsigned x = proj[(size_t)(row0 + 32 * th + j) * NAB + C_VB + h * 256 + e]; if (j & 1) vp[j >> 1] |= x << 16; else vp[j >> 1] = x; }
        LAS v4u* dst = (LAS v4u*)(VT + e * 72 + 32 * th);
#pragma unroll
        for (int q = 0; q < 4; ++q) dst[q] = (v4u){vp[4 * q], vp[4 * q + 1], vp[4 * q + 2], vp[4 * q + 3]};
    }
    WG_SYNC();
    {
        f32x4 acc[2][8];
#pragma unroll
        for (int mi = 0; mi < 2; ++mi)
#pragma unroll
            for (int ni = 0; ni < 8; ++ni) acc[mi][ni] = (f32x4){0.f, 0.f, 0.f, 0.f};
#pragma unroll
        for (int ks = 0; ks < 2; ++ks) {
            bf16x8 a[2]; a[0] = frag16(VT, 72, 16 * (2 * F.wave), 32 * ks, F.lane); a[1] = frag16(VT, 72, 16 * (2 * F.wave + 1), 32 * ks, F.lane);
#pragma unroll
            for (int ni = 0; ni < 8; ++ni) { const bf16x8 bq = frag16(KT, 72, 16 * ni, 32 * ks, F.lane); acc[0][ni] = MFMA16(bq, a[0], acc[0][ni]); acc[1][ni] = MFMA16(bq, a[1], acc[1][ni]); }
        }
        bf16* dsb = DS + ((size_t)(bh * 64 + c) << 15);
#pragma unroll
        for (int mi = 0; mi < 2; ++mi)
#pragma unroll
            for (int ni = 0; ni < 8; ++ni) { const int e = 16 * (2 * F.wave + mi) + (F.lane & 15), d0 = 16 * ni + 4 * (F.lane >> 4);
                const f32x4 dc = *(const LAS f32x4*)(DECs + d0); const f32x4 v = acc[mi][ni] * dc;
                v2u o; o.x = pk2(v.x, v.y); o.y = pk2(v.z, v.w); *(GAS v2u*)(dsb + e * 128 + d0) = o; }
    }
    WG_SYNC();
}

__device__ __forceinline__ void gla_scan(Frame& F) {
    const bf16* DS = (const bf16*)(F.ws + WS_DS); const float* DEC = (const float*)(F.ws + WS_DEC); bf16* ST = (bf16*)(F.ws + WS_ST);
    for (int el = (int)blockIdx.x * 512 + F.tid; el < 8 * 32768; el += F.G * 512) {
        const int bh = el >> 15, ed = el & 32767, d = el & 127; float S = 0.f;
#pragma unroll 8
        for (int c = 0; c < 64; ++c) { const size_t off = ((size_t)(bh * 64 + c) << 15) + ed; const float ds = bf2f(DS[off]), dc = DEC[(bh * 64 + c) * 128 + d];
            ST[off] = (bf16)f2bf(S); S = dc * S + ds; }
    }
}

__device__ __forceinline__ void gla_c_unit(Frame& F, int unit, const float* gnorm_g) {
    const int bh = unit >> 6, c = unit & 63, b = bh >> 2, h = bh & 3; const int row0 = b * SEQ + c * 64;
    const bf16* proj = (const bf16*)(F.ws + WS_PROJ); const bf16* GQ = (const bf16*)(F.ws + WS_GQ); const bf16* GK = (const bf16*)(F.ws + WS_GK);
    const bf16* ST = (const bf16*)(F.ws + WS_ST) + ((size_t)(bh * 64 + c) << 15); bf16* CAT = (bf16*)(F.ws + WS_CAT);
    LAS bf16* QT = (LAS bf16*)(F.lds);
    LAS bf16* KT = (LAS bf16*)(F.lds + 17408);
    LAS bf16* ATT = (LAS bf16*)(F.lds + 34816);
    LAS bf16* SH = (LAS bf16*)(F.lds + 44032);
    LAS bf16* VH = (LAS bf16*)(F.lds + 44032 + 34816);
    LAS float* OT = (LAS float*)(F.lds + 44032);
    const int tid = F.tid, lane = F.lane, w = F.wave;
#pragma unroll
    for (int i = 0; i < 2; ++i) { const int idx = tid + 512 * i, t = idx >> 4, ch = idx & 15;
        *(LAS v4u*)(QT + t * 136 + 8 * ch) = *(const GAS v4u*)(GQ + (size_t)(row0 + t) * 512 + h * 128 + 8 * ch);
        *(LAS v4u*)(KT + t * 136 + 8 * ch) = *(const GAS v4u*)(GK + (size_t)(row0 + t) * 512 + h * 128 + 8 * ch); }
    WG_SYNC();
    {
        const int mi = w >> 1; f32x4 a2[2] = {(f32x4){0.f, 0.f, 0.f, 0.f}, (f32x4){0.f, 0.f, 0.f, 0.f}};
#pragma unroll
        for (int ks = 0; ks < 4; ++ks) { const bf16x8 a = frag16(QT, 136, 16 * mi, 32 * ks, lane);
#pragma unroll
            for (int q = 0; q < 2; ++q) { const bf16x8 bq = frag16(KT, 136, 16 * (2 * (w & 1) + q), 32 * ks, lane); a2[q] = MFMA16(a, bq, a2[q]); } }
#pragma unroll
        for (int q = 0; q < 2; ++q)
#pragma unroll
            for (int j = 0; j < 4; ++j) { const int t = 16 * mi + 4 * (lane >> 4) + j, jj = 16 * (2 * (w & 1) + q) + (lane & 15); ATT[t * 72 + jj] = (bf16)f2bf(jj <= t ? a2[q][j] : 0.f); }
    }
    f32x4 acc[2][4];
#pragma unroll
    for (int H = 0; H < 2; ++H) {
        WG_SYNC();
#pragma unroll
        for (int i = 0; i < 4; ++i) { const int idx = tid + 512 * i, er = idx >> 4, ch = idx & 15;
            *(LAS v4u*)(SH + er * 136 + 8 * ch) = *(const GAS v4u*)(ST + (size_t)(128 * H + er) * 128 + 8 * ch); }
        { const int er = tid & 127, tq = tid >> 7; unsigned vp[8];
#pragma unroll
          for (int j = 0; j < 16; ++j) { const unsigned x = proj[(size_t)(row0 + 16 * tq + j) * NAB + C_VB + h * 256 + 128 * H + er]; if (j & 1) vp[j >> 1] |= x << 16; else vp[j >> 1] = x; }
          LAS v4u* dst = (LAS v4u*)(VH + er * 72 + 16 * tq); dst[0] = (v4u){vp[0], vp[1], vp[2], vp[3]}; dst[1] = (v4u){vp[4], vp[5], vp[6], vp[7]}; }
        WG_SYNC();
        const int mi = w & 3, nb = 4 * (w >> 2);
#pragma unroll
        for (int q = 0; q < 4; ++q) acc[H][q] = (f32x4){0.f, 0.f, 0.f, 0.f};
#pragma unroll
        for (int ks = 0; ks < 4; ++ks) { const bf16x8 a = frag16(QT, 136, 16 * mi, 32 * ks, lane);
#pragma unroll
            for (int q = 0; q < 4; ++q) { const bf16x8 bq = frag16(SH, 136, 16 * (nb + q), 32 * ks, lane); acc[H][q] = MFMA16(a, bq, acc[H][q]); } }
#pragma unroll
        for (int ks = 0; ks < 2; ++ks) { const bf16x8 a = frag16(ATT, 72, 16 * mi, 32 * ks, lane);
#pragma unroll
            for (int q = 0; q < 4; ++q) { const bf16x8 bq = frag16(VH, 72, 16 * (nb + q), 32 * ks, lane); acc[H][q] = MFMA16(a, bq, acc[H][q]); } }
    }
    WG_SYNC();
    { const int mi = w & 3, nb = 4 * (w >> 2);
#pragma unroll
      for (int H = 0; H < 2; ++H)
#pragma unroll
        for (int q = 0; q < 4; ++q)
#pragma unroll
            for (int j = 0; j < 4; ++j) OT[(16 * mi + 4 * (lane >> 4) + j) * 260 + 128 * H + 16 * (nb + q) + (lane & 15)] = acc[H][q][j]; }
    WG_SYNC();
    const f32x4 gg = *(const GAS f32x4*)(gnorm_g + 4 * lane);
#pragma unroll 2
    for (int i = 0; i < 8; ++i) { const int t = 8 * w + i; const size_t row = (size_t)(row0 + t);
        const f32x4 o = *(const LAS f32x4*)(OT + t * 260 + 4 * lane);
        const float ss = wave_sum((o.x * o.x + o.y * o.y) + (o.z * o.z + o.w * o.w)); const float rstd = 1.0f / sqrtf(ss * (1.f / 256.f) + EPS);
        const v2u rb = *(const GAS v2u*)(proj + row * NAB + C_RB + h * 256 + 4 * lane);
        const float r0 = bflo(rb.x), r1 = bfhi(rb.x), r2 = bflo(rb.y), r3 = bfhi(rb.y);
        const float s0 = r0 * __builtin_amdgcn_rcpf(1.f + fexp(-r0)), s1 = r1 * __builtin_amdgcn_rcpf(1.f + fexp(-r1)), s2 = r2 * __builtin_amdgcn_rcpf(1.f + fexp(-r2)), s3 = r3 * __builtin_amdgcn_rcpf(1.f + fexp(-r3));
        v2u out; out.x = pk2(o.x * rstd * gg.x * s0, o.y * rstd * gg.y * s1); out.y = pk2(o.z * rstd * gg.z * s2, o.w * rstd * gg.w * s3);
        *(GAS v2u*)(CAT + row * D + 1024 + h * 256 + 4 * lane) = out; }
    WG_SYNC();
}

__device__ __forceinline__ void attn_all(Frame& F, char* lds_generic) {
    const __hip_bfloat16* proj = (const __hip_bfloat16*)(F.ws + WS_PROJ); __hip_bfloat16* oraw = (__hip_bfloat16*)(F.ws + WS_ORAW);
    const int vv = F.vcu;
    const int bhm = vv >> 3, s = vv & 7, b = bhm >> 4, h = (bhm >> 1) & 7, m = bhm & 1;
    {
        const float* bt = (const float*)(F.ws + WS_BIAS) + h * 128;
        if (F.tid < 128) ((LAS float*)(F.lds + attn_body::LDS_TAB))[F.tid] = bt[F.tid];
        WG_SYNC();
    }
    const size_t rb = (size_t)b * SEQ;
#ifndef ATTN_REPS
#define ATTN_REPS 4
#endif
    for (int i = 0; i < ATTN_REPS; ++i) { const int vh = (i >> 1) & 1, qb = (i & 1) ? 15 - s : s;
        attn_body::attn_unit<8>(qb, proj + rb * NAB + C_QA + h * 128 + m * 64, proj + rb * NAB + C_KA + h * 128 + m * 64, proj + rb * NAB + C_VA + h * 128 + vh * 64,
                     oraw + rb * 2048 + m * 1024 + h * 128 + vh * 64, lds_generic); }
}

__device__ __forceinline__ void attn_all2(Frame& F, char* lds_generic) {
    const __hip_bfloat16* proj = (const __hip_bfloat16*)(F.ws + WS_PROJ); __hip_bfloat16* oraw = (__hip_bfloat16*)(F.ws + WS_ORAW);
    const int vv = F.vcu;
    const int bhm = vv >> 3, s = vv & 7, b = bhm >> 4, h = (bhm >> 1) & 7, m = bhm & 1;
    {   const float* bt = (const float*)(F.ws + WS_BIAS) + h * 128;
        if (F.tid < 128) ((LAS float*)(F.lds + attn_body::LDS2_TAB))[F.tid] = bt[F.tid];
        WG_SYNC();
    }
    const size_t rb = (size_t)b * SEQ;
    for (int i = 0; i < 2; ++i) { const int qb = i ? 15 - s : s;
        attn_body::attn_unit2<8>(qb, proj + rb * NAB + C_QA + h * 128 + m * 64, proj + rb * NAB + C_KA + h * 128 + m * 64, proj + rb * NAB + C_VA + h * 128,
                     oraw + rb * 2048 + m * 1024 + h * 128, lds_generic); }
}

__device__ __forceinline__ void diff_combine(Frame& F, const float* lam_vec, const float* subln_g) {
    const int gw = F.vcu * NWAVES + F.wave, NGW = F.G * NWAVES, lane = F.lane;
    const float s01 = wave_sum(lam_vec[lane] * lam_vec[64 + lane]), s23 = wave_sum(lam_vec[128 + lane] * lam_vec[192 + lane]);
    const float lam = expf(s01) - expf(s23) + 0.2f;
    const bf16* ORAW = (const bf16*)(F.ws + WS_ORAW); bf16* CAT = (bf16*)(F.ws + WS_CAT);
    float g[16];
#pragma unroll
    for (int i = 0; i < 16; ++i) g[i] = subln_g[(16 * lane + i) & 127] * 0.8f;
    for (int row = gw; row < T; row += NGW) {
        const GAS v4u* p0 = (const GAS v4u*)(ORAW + (size_t)row * 2048 + 16 * lane); const GAS v4u* p1 = (const GAS v4u*)(ORAW + (size_t)row * 2048 + 1024 + 16 * lane);
        const v4u a0 = p0[0], a1 = p0[1], b0 = p1[0], b1 = p1[1];
        const unsigned aw[8] = {a0.x, a0.y, a0.z, a0.w, a1.x, a1.y, a1.z, a1.w}, bw[8] = {b0.x, b0.y, b0.z, b0.w, b1.x, b1.y, b1.z, b1.w};
        float o[16]; float ss = 0.f;
#pragma unroll
        for (int i = 0; i < 8; ++i) { o[2 * i] = bflo(aw[i]) - lam * bflo(bw[i]); o[2 * i + 1] = bfhi(aw[i]) - lam * bfhi(bw[i]); ss += o[2 * i] * o[2 * i] + o[2 * i + 1] * o[2 * i + 1]; }
        ss += __shfl_xor(ss, 1); ss += __shfl_xor(ss, 2); ss += __shfl_xor(ss, 4);
        const float rstd = 1.0f / sqrtf(ss * (1.f / 128.f) + EPS);
        unsigned ow[8];
#pragma unroll
        for (int i = 0; i < 8; ++i) ow[i] = pk2(o[2 * i] * rstd * g[2 * i], o[2 * i + 1] * rstd * g[2 * i + 1]);
        GAS v4u* po = (GAS v4u*)(CAT + (size_t)row * D + 16 * lane); po[0] = (v4u){ow[0], ow[1], ow[2], ow[3]}; po[1] = (v4u){ow[4], ow[5], ow[6], ow[7]};
    }
}

struct SpArgs { const float *ln_g, *ln_b, *w_sp, *b_sp; };
__device__ __forceinline__ void spatial_unit(Frame& F, int unit, const SpArgs& sa) {
    const int g = unit & 7, cc = (unit >> 3) & 31, b = unit >> 8; const int row0 = b * SEQ + cc * 128;
    const bf16* UV = (const bf16*)(F.ws + WS_PROJ); bf16* CAT = (bf16*)(F.ws + WS_CAT); const float* stats = (const float*)(F.ws + WS_STATS);
    LAS bf16* WS = (LAS bf16*)(F.lds);
    LAS bf16* VN = (LAS bf16*)(F.lds + 34816);
    LAS bf16* ZS = (LAS bf16*)(F.lds + 34816);
    LAS float* MU = (LAS float*)(F.lds + 104448);
    LAS float* RS = MU + 128;
    const int tid = F.tid, lane = F.lane, w = F.wave;
    if (tid < 128) { const size_t row = (size_t)(row0 + tid); float s1 = 0.f, s2 = 0.f;
#pragma unroll
        for (int q = 0; q < 16; ++q) { const f32x4 p = *(const GAS f32x4*)(stats + row * 64 + 4 * q); s1 += p.x; s2 += p.y; s1 += p.z; s2 += p.w; }
        const float mu = s1 * (1.f / 2048.f);
        const float var = fmaxf(s2 * (1.f / 2048.f) - mu * mu, 0.f); MU[tid] = mu; RS[tid] = 1.0f / sqrtf(var + EPS); }
#pragma unroll
    for (int i = 0; i < 8; ++i) { const int idx = tid + 512 * i, t = idx >> 5, s4 = (idx & 31) * 4;
        const f32x4 x = *(const GAS f32x4*)(sa.w_sp + ((size_t)(g * 128 + t)) * 128 + s4);
        v2u o; o.x = pk2(s4 <= t ? x.x : 0.f, s4 + 1 <= t ? x.y : 0.f); o.y = pk2(s4 + 2 <= t ? x.z : 0.f, s4 + 3 <= t ? x.w : 0.f);
        *(LAS v2u*)(WS + t * 136 + s4) = o; }
    WG_SYNC();
    { const int col = tid & 255, sh = tid >> 8; const float lg = sa.ln_g[g * 256 + col], lb = sa.ln_b[g * 256 + col];
#pragma unroll 2
      for (int s8 = 0; s8 < 8; ++s8) { const int s0 = 64 * sh + 8 * s8; unsigned pk[4];
#pragma unroll
          for (int j = 0; j < 8; ++j) { const int s = s0 + j; const float v = bf2f(UV[(size_t)(row0 + s) * 4096 + 2048 + g * 256 + col]);
              const unsigned x = f2bf((v - MU[s]) * RS[s] * lg + lb); if (j & 1) pk[j >> 1] |= x << 16; else pk[j >> 1] = x; }
          *(LAS v4u*)(VN + col * 136 + s0) = (v4u){pk[0], pk[1], pk[2], pk[3]}; } }
    WG_SYNC();
    f32x4 acc[8][2];
#pragma unroll
    for (int mi = 0; mi < 8; ++mi) { acc[mi][0] = (f32x4){0.f, 0.f, 0.f, 0.f}; acc[mi][1] = (f32x4){0.f, 0.f, 0.f, 0.f}; }
#pragma unroll
    for (int ks = 0; ks < 4; ++ks) { const bf16x8 b0 = frag16(VN, 136, 16 * (2 * w), 32 * ks, lane), b1 = frag16(VN, 136, 16 * (2 * w + 1), 32 * ks, lane);
#pragma unroll
        for (int mi = 0; mi < 8; ++mi) if (mi >= 2 * ks) { const bf16x8 a = frag16(WS, 136, 16 * mi, 32 * ks, lane); acc[mi][0] = MFMA16(a, b0, acc[mi][0]); acc[mi][1] = MFMA16(a, b1, acc[mi][1]); } }
    WG_SYNC();
#pragma unroll
    for (int mi = 0; mi < 8; ++mi)
#pragma unroll
        for (int j = 0; j < 4; ++j) { const int t = 16 * mi + 4 * (lane >> 4) + j; const float bs = sa.b_sp[g * 128 + t];
#pragma unroll
            for (int q = 0; q < 2; ++q) ZS[t * 264 + 16 * (2 * w + q) + (lane & 15)] = (bf16)f2bf(acc[mi][q][j] + bs); }
    WG_SYNC();
#pragma unroll
    for (int i = 0; i < 8; ++i) { const int idx = tid + 512 * i, t = idx >> 5, ch = idx & 31;
        const v4u z = *(const LAS v4u*)(ZS + t * 264 + 8 * ch); const v4u u = *(const GAS v4u*)(UV + (size_t)(row0 + t) * 4096 + g * 256 + 8 * ch);
        v4u o; o.x = pk2(bflo(z.x) * bflo(u.x), bfhi(z.x) * bfhi(u.x)); o.y = pk2(bflo(z.y) * bflo(u.y), bfhi(z.y) * bfhi(u.y));
        o.z = pk2(bflo(z.z) * bflo(u.z), bfhi(z.z) * bfhi(u.z)); o.w = pk2(bflo(z.w) * bflo(u.w), bfhi(z.w) * bfhi(u.w));
        *(GAS v4u*)(CAT + (size_t)(row0 + t) * D + g * 256 + 8 * ch) = o; }
    WG_SYNC();
}

#if defined(DBG_NAIVE_ATTN)
__device__ __forceinline__ void dbg_attn(Frame& F, const float* lam_vec, const float* subln_g, const float* rel_bias) {
    const bf16* proj = (const bf16*)(F.ws + WS_PROJ); bf16* CAT = (bf16*)(F.ws + WS_CAT);
    LAS float* W = (LAS float*)(F.lds) + F.wave * 4096;
    const int gw = F.vcu * NWAVES + F.wave, NGW = F.G * NWAVES, lane = F.lane;
    const float s01 = wave_sum(lam_vec[lane] * lam_vec[64 + lane]), s23 = wave_sum(lam_vec[128 + lane] * lam_vec[192 + lane]);
    const float lam = expf(s01) - expf(s23) + 0.2f;
    for (int task = gw; task < 2 * 8 * SEQ; task += NGW) {
        const int b = task / (8 * SEQ), h = (task / SEQ) & 7, q = task % SEQ; const size_t rb = (size_t)b * SEQ;
        float o0 = 0.f, o1 = 0.f;
        for (int m = 0; m < 2; ++m) {
            float qv[64];
#pragma unroll
            for (int d = 0; d < 64; ++d) qv[d] = bf2f(proj[(rb + q) * NAB + C_QA + h * 128 + m * 64 + d]);
            float mx = -INFINITY;
            for (int j = lane; j <= q; j += 64) { const bf16* kr = proj + (rb + j) * NAB + C_KA + h * 128 + m * 64; float s = 0.f;
#pragma unroll
                for (int d = 0; d < 64; ++d) s += qv[d] * bf2f(kr[d]);
                const int rel = q - j; const int bk = rel < 128 ? (int)T5_BUCKET[rel] : 31; s += rel_bias[bk * 8 + h] * LOG2E; W[j] = s; mx = fmaxf(mx, s); }
#pragma unroll
            for (int o = 1; o < 64; o <<= 1) mx = fmaxf(mx, __shfl_xor(mx, o));
            float l = 0.f;
            for (int j = lane; j <= q; j += 64) { const float p = exp2f(W[j] - mx); W[j] = p; l += p; }
            l = wave_sum(l); LDS_WAIT();
            float a0 = 0.f, a1 = 0.f;
            for (int j = 0; j <= q; ++j) { const float p = W[j]; const unsigned vv = *(const unsigned*)(proj + (rb + j) * NAB + C_VA + h * 128 + 2 * lane); a0 += p * bflo(vv); a1 += p * bfhi(vv); }
            const float sc = (m == 0 ? 1.f : -lam) / l; o0 += sc * a0; o1 += sc * a1; LDS_WAIT();
        }
        const float ss = wave_sum(o0 * o0 + o1 * o1); const float rstd = 1.0f / sqrtf(ss * (1.f / 128.f) + EPS);
        *(unsigned*)(CAT + (rb + q) * D + h * 128 + 2 * lane) = pk2(o0 * rstd * subln_g[2 * lane] * 0.8f, o1 * rstd * subln_g[2 * lane + 1] * 0.8f);
    }
}
#endif
#if defined(DBG_NAIVE_GLA)
__device__ __forceinline__ void dbg_gla_rec(Frame& F, const float* w_gk, const float* b_gk) {
    const bf16* proj = (const bf16*)(F.ws + WS_PROJ); const float* gb = (const float*)(F.ws + WS_GB); float* OB = (float*)(F.ws + WS_DS);
    for (int task = F.vcu; task < 256; task += F.G) {
        const int bh = task >> 5, es = task & 31, b = bh >> 2, h = bh & 3;
        const int dh = F.wave & 1, eq = F.wave >> 1, d = dh * 64 + F.lane, e0 = es * 8 + 2 * eq;
        float wg[16];
#pragma unroll
        for (int r = 0; r < 16; ++r) wg[r] = w_gk[r * 512 + h * 128 + d];
        const float bias = b_gk[h * 128 + d];
        float s0 = 0.f, s1 = 0.f;
        for (int t = 0; t < SEQ; ++t) { const size_t row = (size_t)b * SEQ + t;
            float x = bias;
#pragma unroll
            for (int r = 0; r < 16; ++r) x += gb[row * 16 + r] * wg[r];
            const float a = expf(log_sigmoid(x) * (1.f / 16.f));
            const float k = bf2f(proj[row * NAB + C_KB + h * 128 + d]), q = bf2f(proj[row * NAB + C_QB + h * 128 + d]) * 0.08838834764831845f;
            const unsigned vv = *(const unsigned*)(proj + row * NAB + C_VB + h * 256 + e0);
            s0 = a * s0 + k * bflo(vv); s1 = a * s1 + k * bfhi(vv);
            const float p0 = wave_sum(q * s0), p1 = wave_sum(q * s1);
            if (F.lane == 0) { OB[((size_t)dh * T + row) * 1024 + h * 256 + e0] = p0; OB[((size_t)dh * T + row) * 1024 + h * 256 + e0 + 1] = p1; }
        }
    }
}
__device__ __forceinline__ void dbg_gla_norm(Frame& F, const float* gnorm_g) {
    const bf16* proj = (const bf16*)(F.ws + WS_PROJ); const float* OB = (const float*)(F.ws + WS_DS); bf16* CAT = (bf16*)(F.ws + WS_CAT);
    const int gw = F.vcu * NWAVES + F.wave, NGW = F.G * NWAVES, lane = F.lane;
    for (int task = gw; task < T * 4; task += NGW) { const int row = task >> 2, h = task & 3;
        float o[4]; float ss = 0.f;
#pragma unroll
        for (int i = 0; i < 4; ++i) { const int e = 4 * lane + i; o[i] = OB[(size_t)row * 1024 + h * 256 + e] + OB[((size_t)T + row) * 1024 + h * 256 + e]; ss += o[i] * o[i]; }
        const float rstd = 1.0f / sqrtf(wave_sum(ss) * (1.f / 256.f) + EPS);
#pragma unroll
        for (int i = 0; i < 4; ++i) { const int e = 4 * lane + i; const float r = bf2f(proj[(size_t)row * NAB + C_RB + h * 256 + e]);
            CAT[(size_t)row * D + 1024 + h * 256 + e] = (bf16)f2bf(o[i] * rstd * gnorm_g[e] * (r / (1.f + expf(-r)))); }
    }
}
#endif
#if defined(DBG_NAIVE_SPATIAL)
__device__ __forceinline__ void dbg_spatial(Frame& F, const float* ln_g, const float* ln_b, const float* w_sp, const float* b_sp) {
    const bf16* UV = (const bf16*)(F.ws + WS_PROJ); bf16* CAT = (bf16*)(F.ws + WS_CAT);
    LAS float* MU = (LAS float*)(F.lds); LAS float* RS = MU + 128;
    for (int task = F.vcu; task < 64; task += F.G) {
        const int row0 = task * 128;
        for (int i = 0; i < 16; ++i) { const int r = 16 * F.wave + i; float s1 = 0.f;
            for (int c = F.lane; c < 2048; c += 64) s1 += bf2f(UV[(size_t)(row0 + r) * 4096 + 2048 + c]);
            const float mu = wave_sum(s1) * (1.f / 2048.f); float s2 = 0.f;
            for (int c = F.lane; c < 2048; c += 64) { const float dlt = bf2f(UV[(size_t)(row0 + r) * 4096 + 2048 + c]) - mu; s2 += dlt * dlt; }
            const float var = wave_sum(s2) * (1.f / 2048.f);
            if (F.lane == 0) { MU[r] = mu; RS[r] = 1.0f / sqrtf(var + EPS); } }
        WG_SYNC();
        for (int ci = 0; ci < 4; ++ci) { const int col = F.tid + 512 * ci, g = col >> 8; const float lg = ln_g[col], lb = ln_b[col];
            for (int t = 0; t < 128; ++t) { float z = b_sp[g * 128 + t];
                for (int s = 0; s <= t; ++s) z += w_sp[(size_t)(g * 128 + t) * 128 + s] * ((bf2f(UV[(size_t)(row0 + s) * 4096 + 2048 + col]) - MU[s]) * RS[s] * lg + lb);
                CAT[(size_t)(row0 + t) * D + col] = (bf16)f2bf(z * bf2f(UV[(size_t)(row0 + t) * 4096 + col])); } }
        WG_SYNC();
    }
}
#endif

enum { I_X = 0, I_RELB, I_NMIX, I_NFFN, I_NFIN, I_WINAB, I_LAM, I_SUBLN, I_WGK, I_BGK, I_GNORM, I_WOUTAB, I_WINC, I_LNG, I_LNB, I_WSP, I_BSP, I_WOUTC, I_WRG, I_WRE, I_WEG, I_WEU, I_WED, N_IN };
struct Args { const float* in[N_IN]; float* out; unsigned char* ws; int ph_lo, ph_hi; };

__device__ __forceinline__ const float* argp(const Args& a, int i) { asm volatile("" : "+s"(i)); return a.in[i]; }
__device__ __forceinline__ void moe_up_setup(Frame& F, pg8::MoeProb<true>& P, int layer) {
    const LAS int* base = (const LAS int*)(F.lds + MOE_OFF);
    P.A = (const bf16*)(F.ws + WS_H); P.Bt = (const bf16*)(F.ws + WS_WGU) + (size_t)layer * NEXP * 1024 * D; P.K = D; P.NPN = 4; P.bstride = (size_t)1024 * D * 2;
    P.U = base[64] * 4; P.lcount = P.U; P.l1 = 1 << 28; P.lstride = 0; P.use_list = false; P.split = false; P.split_base = 0; P.cnt = base; P.mt_e = base + 65; P.mt_s0 = base + 161; P.mlist = base + 257; P.list = (const int*)(F.ws + WS_LIST);
}
__device__ __forceinline__ void moe_down_setup(Frame& F, pg8::MoeProb<false>& P, int layer) {
    const LAS int* base = (const LAS int*)(F.lds + MOE_OFF);
    P.A = (const bf16*)(F.ws + WS_ACT); P.Bt = (const bf16*)(F.ws + WS_WDN) + (size_t)layer * NEXP * D * FF; P.K = FF; P.NPN = 8; P.bstride = (size_t)D * FF * 2;
    P.U = base[64] * 8; P.use_list = true; P.split = false; P.split_base = 0; P.l1 = 1 << 28; P.lstride = 0; P.cnt = base; P.mt_e = base + 65; P.mt_s0 = base + 161; P.list = (const int*)(F.ws + WS_LIST);
}
template <class Prob>
__device__ __forceinline__ void moe_wait_units(Frame& F, const Prob& P, int layer) {
    if (F.wave == 0) {
        gu32* cw = F.ctl + CW_MOEUP + layer * 96 * MOEUP_STRIDE; pg8::Unit u; bool any = false;
        for (int i = 0; P.next(i, u); ++i) { any = true; unsigned spins = 0;
            while (__builtin_amdgcn_readfirstlane(__hip_atomic_load(cw + u.pm * MOEUP_STRIDE, __ATOMIC_RELAXED, __HIP_MEMORY_SCOPE_AGENT)) < 32u) { __builtin_amdgcn_s_sleep(1); if (++spins > (1u << 20)) break; } }
        if (any) { __builtin_amdgcn_fence(__ATOMIC_ACQUIRE, "agent"); asm volatile("s_waitcnt vmcnt(0)" ::: "memory"); }
    }
    WG_SYNC();
}
__device__ __forceinline__ void moe_phase_a(Frame& F, int layer) {
    pg8::MoeProb<true> P; moe_up_setup(F, P, layer); P.l0 = (int)blockIdx.x;
    pg8::EpiSwiglu E{(bf16*)(F.ws + WS_ACT), FF, (unsigned*)(F.ctl + CW_MOEUP + layer * 96 * MOEUP_STRIDE)};
    pg8::gemm_phase<pg8::EpiSwiglu, pg8::MoeProb<true>, true>(F.lds + RING_OFF, P, E);
}
__device__ __forceinline__ void moe_phase_b(Frame& F, int layer) {
    const LAS int* base = (const LAS int*)(F.lds + MOE_OFF);
    const int U = base[64] * 4, G = F.G, n_heavy = U > G ? U - G : 0, c = (int)blockIdx.x, HU = 2 * n_heavy;
    constexpr bool splitmode = false;
    const int nh = splitmode ? HU : n_heavy;
    if (c < nh) {
        pg8::MoeProb<true> P; moe_up_setup(F, P, layer);
        if (splitmode) { P.split = true; P.split_base = G; P.l0 = c; P.lcount = HU; } else { P.l0 = G + c; }
        pg8::EpiSwiglu E{(bf16*)(F.ws + WS_ACT), FF, (unsigned*)(F.ctl + CW_MOEUP + layer * 96 * MOEUP_STRIDE)};
        if (!splitmode) pg8::gemm_phase<pg8::EpiSwiglu, pg8::MoeProb<true>, true>(F.lds + RING_OFF, P, E);
        else if (c & 1) pg8::gemm_phase<pg8::EpiSwiglu, pg8::MoeProb<true>, true, 2>(F.lds + RING_OFF, P, E);
        else pg8::gemm_phase<pg8::EpiSwiglu, pg8::MoeProb<true>, true, 1>(F.lds + RING_OFF, P, E);
    }
    {
        pg8::MoeProb<false> P; moe_down_setup(F, P, layer); P.mlist = base + 257; P.lcount = 8 * base[449];
        if (splitmode) { P.l0 = c; if (c >= nh) { P.l1 = G + (c - nh); P.lstride = G - nh; } }
        else { if (c >= nh) { P.l0 = c - nh; P.l1 = P.l0 + (G - nh); P.lstride = G - nh; } else P.l0 = 1 << 28; }
        pg8::EpiBf16M E{(bf16*)(F.ws + WS_PROJ), D};
        if (!MK_PER_PHASE) moe_wait_units(F, P, layer);
        pg8::gemm_phase<pg8::EpiBf16M, pg8::MoeProb<false>, true>(F.lds + RING_OFF, P, E);
    }
}
__device__ __forceinline__ void moe_phase_c(Frame& F, int layer) {
    const LAS int* base = (const LAS int*)(F.lds + MOE_OFF);
    pg8::MoeProb<false> P; moe_down_setup(F, P, layer); P.mlist = base + 353; P.l0 = (int)blockIdx.x; P.l1 = P.l0 + F.G; P.lstride = F.G; P.lcount = 8 * base[450];
    pg8::EpiBf16M E{(bf16*)(F.ws + WS_PROJ), D};
    if (!MK_PER_PHASE) moe_wait_units(F, P, layer);
    pg8::gemm_phase<pg8::EpiBf16M, pg8::MoeProb<false>, true>(F.lds + RING_OFF, P, E);
}

__global__ void __launch_bounds__(NWAVES * 64, 2) fwd_kernel(Args args) {
    extern __shared__ __attribute__((aligned(16))) unsigned char lds[];
    Frame F;
    F.lds = (LAS unsigned char*)lds;
    F.tid = threadIdx.x; F.lane = F.tid & 63; F.wave = __builtin_amdgcn_readfirstlane(F.tid >> 6);
    F.G = gridDim.x; { const int bx = blockIdx.x; F.vcu = (F.G % 8 == 0) ? (bx % 8) * (F.G / 8) + bx / 8 : bx; }
    F.ws = args.ws; F.ctl = (gu32*)(args.ws + WS_CTL);
    for (int u = F.tid; u < (LDS_BYTES - LDSCTL_OFF) / 4; u += NWAVES * 64) ((LAS unsigned*)(F.lds + LDSCTL_OFF))[u] = 0u;
    __syncthreads();
    XcdBarrier bar; bar.bar = (unsigned*)(F.ctl + CW_BAR); bar.x = 0; bar.st = nullptr;
    if (!MK_PER_PHASE) bar = xcd_barrier_post((unsigned*)(F.ctl + CW_BAR), (volatile LAS unsigned*)(F.lds + MISC_OFF));
    const int lo = args.ph_lo, hi = args.ph_hi;
#ifndef PH_MASK
#define PH_MASK 0xfffff
#endif
#ifndef REPEAT_MASK
#define REPEAT_MASK 0
#endif
#define IN(k) (((PH_MASK >> (k)) & 1) && lo <= (k) && (k) < hi)
#define REP(k) for (int rep_ = 0; rep_ < ((((REPEAT_MASK) >> (k)) & 1) ? 2 : 1); ++rep_)
#define RETID() do { int t_ = threadIdx.x; asm volatile("" : "+v"(t_)); F.tid = t_; F.lane = t_ & 63; } while (0)
#ifndef BAR_REPS
#define BAR_REPS 1
#endif
#define SEAM(k) do { RETID(); if (IN(k) && IN((k) + 1)) { for (int br_ = 0; br_ < BAR_REPS; ++br_) xcd_barrier(bar); } } while (0)
#define SEAM_NB(k) do { RETID(); if (MK_PER_PHASE && IN(k) && IN((k) + 1)) xcd_barrier(bar); } while (0)
#define ARG(i) argp(args, (i))
    const LAS int* tstart = (const LAS int*)(F.lds + MOE_OFF) + 32;

    if (IN(0)) REP(0) {
        P0Args pa{ARG(I_WINAB), ARG(I_WOUTAB), ARG(I_WINC), ARG(I_WOUTC), ARG(I_WEG), ARG(I_WEU), ARG(I_WED), ARG(I_RELB)};
        p0_convert(F, pa, P0_I_AB);
        p0_router_weights(F, ARG(I_WRG), ARG(I_WRE), ARG(I_NFFN));
        WG_SYNC();
        p0_norm_pair(F, ARG(I_X), ARG(I_NMIX), ARG(I_WINAB), (bf16*)(F.ws + WS_H), (float*)(F.ws + WS_GB));
    }
    SEAM(0);
#ifndef NCONV
#define NCONV 16
#endif
    if (IN(1)) {
        P0Args pa{ARG(I_WINAB), ARG(I_WOUTAB), ARG(I_WINC), ARG(I_WOUTC), ARG(I_WEG), ARG(I_WEU), ARG(I_WED), ARG(I_RELB)};
        const int xcd = F.vcu >> 5, li = F.vcu & 31;
        if (li < NCONV) { p0_convert_stream(F, pa, xcd); WG_SYNC(); }
        {   pg8::QueueProb P; P.init((const bf16*)(F.ws + WS_H), (const bf16*)(F.ws + WS_WAB), T, NAB, D, xcd, (unsigned*)(F.ctl + CW_QGEMM + xcd * 64), (volatile LAS int*)(F.lds + MISC_OFF + 32));
            P.prime(); WG_SYNC();
            pg8::EpiBf16S E{(bf16*)(F.ws + WS_PROJ), NAB, 0.125f * LOG2E, 1024};
            pg8::gemm_phase<pg8::EpiBf16S, pg8::QueueProb, true>(F.lds + RING_OFF, P, E); }
        RETID();
        if (li >= NCONV) { WG_SYNC(); p0_convert_stream(F, pa, xcd); }
    }
    SEAM(1);
#if defined(DBG_NAIVE_GLA)
    if (IN(2)) REP(2) dbg_gla_rec(F, ARG(I_WGK), ARG(I_BGK));
    SEAM(2);
    if (IN(3)) REP(3) dbg_gla_norm(F, ARG(I_GNORM));
#else
    if (IN(2)) REP(2) { const GlaArgs ga{ARG(I_WGK), ARG(I_BGK)}; for (int u = F.vcu; u < 512; u += F.G) gla_a_unit(F, u, ga); }
    SEAM(2);
    if (IN(3)) REP(3) gla_scan(F);
#endif
    SEAM(3);
    if (IN(4)) REP(4) {
#if !defined(DBG_NAIVE_GLA)
        for (int r2_ = 0; r2_ < ((((REPEAT_MASK) >> 19) & 1) ? 2 : 1); ++r2_)
        for (int u = F.vcu; u < 512; u += F.G) gla_c_unit(F, u, ARG(I_GNORM));
#endif
#if defined(DBG_NAIVE_ATTN)
        dbg_attn(F, ARG(I_LAM), ARG(I_SUBLN), ARG(I_RELB));
#else
        for (int r2_ = 0; r2_ < ((((REPEAT_MASK) >> 18) & 1) ? 2 : 1); ++r2_)
#if defined(ATTN_V64)
        attn_all(F, (char*)lds + RING_OFF);
#else
        attn_all2(F, (char*)lds + RING_OFF);
#endif
#endif
    }
    SEAM(4);
#if !defined(DBG_NAIVE_ATTN)
    if (IN(5)) REP(5) diff_combine(F, ARG(I_LAM), ARG(I_SUBLN));
#endif
    SEAM(5);
    if (IN(6)) REP(6) {
        pg8::DenseProb P; P.init((const bf16*)(F.ws + WS_CAT), (const bf16*)(F.ws + WS_WOAB), T, D, D, F.G, (int)blockIdx.x);
        pg8::EpiRes E{ARG(I_X), (float*)(F.ws + WS_X), D};
        pg8::gemm_phase<pg8::EpiRes, pg8::DenseProb, false>(F.lds + RING_OFF, P, E);
    }
    SEAM(6);
#define ROUTER_PHASE(layer) do { const bf16* WH_ = (const bf16*)(F.ws + WS_WR) + (size_t)(layer) * 2 * 48 * D; \
        router_pair(F, (layer), ((layer) || !0) ? (const float*)(F.ws + WS_X) : ARG(I_X), ((layer) ? 1 : 0) ? (const bf16*)(F.ws + WS_ORAW) : (const bf16*)nullptr, ARG(I_NFFN) + (size_t)(layer) * D, (bf16*)(F.ws + WS_H), WH_, WH_ + (size_t)48 * D); } while (0)
    if (IN(7)) REP(7) ROUTER_PHASE(0);
    SEAM(7);
    if (IN(8)) REP(8) { moe_tables(F, 0); moe_phase_a(F, 0); }
    SEAM_NB(8);
    if (IN(9)) REP(9) { if (MK_PER_PHASE) moe_tables(F, 0); moe_phase_b(F, 0); }
    SEAM_NB(9);
    if (IN(10)) REP(10) { if (MK_PER_PHASE) moe_tables(F, 0); moe_phase_c(F, 0); }
    SEAM(10);
    if (IN(11)) REP(11) {
        if (MK_PER_PHASE) moe_tables(F, 0);
        for (int b2 = F.vcu * NWAVES + F.wave; b2 < T / 2; b2 += F.G * NWAVES)
            rows4<true, 0, 0, NoSrc4, 2>(F, 2 * b2, (const float*)(F.ws + WS_X), (float*)(F.ws + WS_X), ARG(I_NMIX) + D, (bf16*)(F.ws + WS_H), nullptr,
                                      (const int*)(F.ws + WS_TOK), (const float*)(F.ws + WS_TOK + 262144), (const bf16*)(F.ws + WS_PROJ), tstart, NoSrc4{}, nullptr, (const bf16*)nullptr);
    }
    SEAM(11);
    if (IN(12)) REP(12) {
        pg8::DenseProb P; P.init((const bf16*)(F.ws + WS_H), (const bf16*)(F.ws + WS_WINC), T, 2 * D, D, F.G, (int)blockIdx.x);
        pg8::EpiGelu E{(bf16*)(F.ws + WS_PROJ), 2 * D, (float*)(F.ws + WS_STATS), D};
        pg8::gemm_phase<pg8::EpiGelu, pg8::DenseProb, true>(F.lds + RING_OFF, P, E);
    }
    SEAM(12);
#if defined(DBG_NAIVE_SPATIAL)
    if (IN(13)) REP(13) dbg_spatial(F, ARG(I_LNG), ARG(I_LNB), ARG(I_WSP), ARG(I_BSP));
#else
    if (IN(13)) REP(13) { const SpArgs sa{ARG(I_LNG), ARG(I_LNB), ARG(I_WSP), ARG(I_BSP)}; for (int u = F.vcu; u < 512; u += F.G) spatial_unit(F, u, sa); }
#endif
    SEAM(13);
    if (IN(14)) REP(14) {
        pg8::DenseProb P; P.init((const bf16*)(F.ws + WS_CAT), (const bf16*)(F.ws + WS_WOC), T, D, D, F.G, (int)blockIdx.x);
        pg8::EpiBf16S E{(bf16*)(F.ws + WS_ORAW), D, 1.f, 0};
        pg8::gemm_phase<pg8::EpiBf16S, pg8::DenseProb, true>(F.lds + RING_OFF, P, E);
    }
    SEAM(14);
    if (IN(15)) REP(15) ROUTER_PHASE(1);
    SEAM(15);
    if (IN(16)) REP(16) { moe_tables(F, 1); moe_phase_a(F, 1); }
    SEAM_NB(16);
    if (IN(17)) REP(17) { if (MK_PER_PHASE) moe_tables(F, 1); moe_phase_b(F, 1); }
    SEAM_NB(17);
    if (IN(18)) REP(18) { if (MK_PER_PHASE) moe_tables(F, 1); moe_phase_c(F, 1); }
    SEAM(18);
    if (IN(19)) REP(19) {
        if (MK_PER_PHASE) moe_tables(F, 1);
        for (int b2 = F.vcu * NWAVES + F.wave; b2 < T / 2; b2 += F.G * NWAVES)
            rows4<true, 1, 0, NoSrc4, 2>(F, 2 * b2, (const float*)(F.ws + WS_X), nullptr, ARG(I_NFIN), nullptr, args.out,
                                      (const int*)(F.ws + WS_TOK), (const float*)(F.ws + WS_TOK + 262144), (const bf16*)(F.ws + WS_PROJ), tstart, NoSrc4{}, nullptr, (const bf16*)(F.ws + WS_ORAW));
    }
#undef IN
#undef SEAM
#undef ROUTER_PHASE
#undef ARG
}

extern "C" void kernel_launch(void* const* d_in, const int* in_sizes, int n_in, void* d_out, int out_size, void* d_ws, size_t ws_size, hipStream_t stream) {
    static int grid = 0;
    if (grid == 0) {
        if (n_in != N_IN || in_sizes[0] != T * D || out_size != T * D || ws_size < WS_END) {
            fprintf(stderr, "kernel_launch: built for %d inputs, x/out of %d floats, >= %zu bytes of workspace; got n_in %d, in0 %d, out %d, ws %zu; nothing launched\n", (int)N_IN, T * D, (size_t)WS_END, n_in, n_in > 0 ? in_sizes[0] : -1, out_size, ws_size);
            grid = -1; return; }
        int dev = 0, cus = 0, per_cu = 0;
        if (hipGetDevice(&dev) != hipSuccess || hipDeviceGetAttribute(&cus, hipDeviceAttributeMultiprocessorCount, dev) != hipSuccess) { fprintf(stderr, "kernel_launch: device query failed\n"); grid = -1; return; }
        if (hipFuncSetAttribute((const void*)fwd_kernel, hipFuncAttributeMaxDynamicSharedMemorySize, LDS_BYTES) != hipSuccess) { fprintf(stderr, "kernel_launch: hipFuncSetAttribute failed\n"); grid = -1; return; }
        if (hipOccupancyMaxActiveBlocksPerMultiprocessor(&per_cu, (const void*)fwd_kernel, NWAVES * 64, LDS_BYTES) != hipSuccess || per_cu < 1)
            fprintf(stderr, "kernel_launch: note: occupancy query reports %d workgroups per CU\n", per_cu);
        (void)hipGetLastError();
        grid = cus;
        if (grid != 256) { fprintf(stderr, "kernel_launch: this kernel needs a 256-CU device (got %d)\n", cus); grid = -1; return; }
    }
    if (grid < 0) return;
    if (hipMemsetAsync((char*)d_ws + WS_CTL, 0, CTL_ZERO_BYTES, stream) != hipSuccess) { fprintf(stderr, "kernel_launch: hipMemsetAsync failed\n"); return; }
    Args a{};
    for (int i = 0; i < N_IN; ++i) a.in[i] = (const float*)d_in[i];
    a.out = (float*)d_out; a.ws = (unsigned char*)d_ws;
#if MK_PER_PHASE
    for (int p = 0; p < NPHASE; ++p) { a.ph_lo = p; a.ph_hi = p + 1; hipLaunchKernelGGL(fwd_kernel, dim3(grid), dim3(NWAVES * 64), LDS_BYTES, stream, a); }
#else
    a.ph_lo = 0; a.ph_hi = NPHASE; hipLaunchKernelGGL(fwd_kernel, dim3(grid), dim3(NWAVES * 64), LDS_BYTES, stream, a);
#endif
    const hipError_t le = hipPeekAtLastError();
    if (le != hipSuccess) fprintf(stderr, "kernel_launch: launch failed: %s\n", hipGetErrorName(le));
}
```
